# Optimizing an MI355X kernel written in HIP

```python
import jax, jax.numpy as jnp
from jax import lax
import numpy as np

D_MODEL = 2048
BATCH = 8
SEQ = 4096
DEPTH = 1

CHUNK = 64
D_MIX = D_MODEL
D_CONV = D_MIX // 2
CONV_WIDTH = 31
D_MLSTM = D_MIX - D_CONV
MLSTM_HEADS = 4
DV = D_MLSTM // MLSTM_HEADS
DK = DV // 2
N_EXPERTS = 32
TOP_K = 4
D_EXPERT = D_MODEL
SWIGLU_ALPHA = 1.702
SWIGLU_LIMIT = 7.0
MOE_BLOCK = 256
LN_EPS = 1e-5
DEEPNORM_ALPHA = (2 * DEPTH) ** 0.25
DEEPNORM_BETA = (8 * DEPTH) ** -0.25
IN_SIZES = (D_CONV, D_CONV, MLSTM_HEADS * DK, MLSTM_HEADS * DK, D_MLSTM, D_MLSTM, MLSTM_HEADS, MLSTM_HEADS)
D_IN = sum(IN_SIZES)
SPLIT_POINTS = tuple(int(s) for s in np.cumsum(IN_SIZES)[:-1])

kernel_name = 'hymba_conformer_mlstm_moe_deepnorm'


def layer_norm(x, gain=None, bias=None):
    xf = x.astype(jnp.float32)
    mu = jnp.mean(xf, axis=-1, keepdims=True)
    var = jnp.mean(jnp.square(xf - mu), axis=-1, keepdims=True)
    y = (xf - mu) * lax.rsqrt(var + LN_EPS)
    if gain is not None:
        y = y * gain.astype(jnp.float32) + bias.astype(jnp.float32)
    return y.astype(x.dtype)


def conformer_conv(val, gate, dw_w, dw_b, ln_g, ln_b):
    u = val * jax.nn.sigmoid(gate)
    y = lax.conv_general_dilated(
        u, dw_w[:, None, :].astype(u.dtype), window_strides=(1,),
        padding=[(CONV_WIDTH - 1, 0)],
        dimension_numbers=('NWC', 'WIO', 'NWC'), feature_group_count=D_CONV)
    y = y + dw_b
    return jax.nn.silu(layer_norm(y, ln_g, ln_b))


def mlstm_chunkwise(q, k, v, i_pre, f_pre):
    bsz, seq = q.shape[:2]
    n_chunks = seq // CHUNK

    def to_chunks(z):
        z = z.astype(jnp.float32).reshape(bsz, n_chunks, CHUNK, MLSTM_HEADS, -1)
        return z.transpose(1, 0, 3, 2, 4)

    qc = to_chunks(q)
    kc = to_chunks(k) * (DK ** -0.5)
    vc = to_chunks(v)
    ic = to_chunks(i_pre[..., None])[..., 0]
    lfc = jax.nn.log_sigmoid(to_chunks(f_pre[..., None])[..., 0])
    causal = jnp.tril(jnp.ones((CHUNK, CHUNK), dtype=bool))

    def step(carry, inp):
        c_mat, n_vec, m = carry
        q_, k_, v_, ig, lf = inp
        b = jnp.cumsum(lf, axis=-1)
        dmat = jnp.where(causal, b[..., :, None] - b[..., None, :] + ig[..., None, :], -jnp.inf)
        inter = b + m[..., None]
        m_q = jnp.maximum(inter, jnp.max(dmat, axis=-1))
        s = jnp.einsum('bhld,bhsd->bhls', q_, k_) * jnp.exp(dmat - m_q[..., None])
        w_inter = jnp.exp(inter - m_q)
        num = jnp.einsum('bhls,bhsv->bhlv', s, v_) + w_inter[..., None] * jnp.einsum('bhld,bhdv->bhlv', q_, c_mat)
        den = jnp.sum(s, axis=-1) + w_inter * jnp.einsum('bhld,bhd->bhl', q_, n_vec)
        h = num / jnp.maximum(jnp.abs(den), jnp.exp(-m_q))[..., None]
        b_last = b[..., -1]
        gain = b_last[..., None] - b + ig
        m_new = jnp.maximum(b_last + m, jnp.max(gain, axis=-1))
        wk = jnp.exp(gain - m_new[..., None])
        decay = jnp.exp(b_last + m - m_new)
        c_mat = decay[..., None, None] * c_mat + jnp.einsum('bhs,bhsd,bhsv->bhdv', wk, k_, v_)
        n_vec = decay[..., None] * n_vec + jnp.einsum('bhs,bhsd->bhd', wk, k_)
        return (c_mat, n_vec, m_new), h

    init = (jnp.zeros((bsz, MLSTM_HEADS, DK, DV), jnp.float32),
            jnp.zeros((bsz, MLSTM_HEADS, DK), jnp.float32),
            jnp.zeros((bsz, MLSTM_HEADS), jnp.float32))
    _, hc = lax.scan(step, init, (qc, kc, vc, ic, lfc))
    return hc.transpose(1, 0, 3, 2, 4).reshape(bsz, seq, MLSTM_HEADS, DV)


def clamped_swiglu(a, u):
    a = jnp.minimum(a, SWIGLU_LIMIT)
    u = jnp.clip(u, -SWIGLU_LIMIT, SWIGLU_LIMIT)
    return a * jax.nn.sigmoid(SWIGLU_ALPHA * a) * (u + 1.0)


def moe_ffn(h, router_w, router_b, w_gate, b_gate, w_up, b_up, w_down, b_down):
    bsz, seq, d = h.shape
    n_tok = bsz * seq
    n_assign = n_tok * TOP_K
    n_blocks = -(-n_assign // MOE_BLOCK) + N_EXPERTS
    xt = h.reshape(n_tok, d)
    logits = (xt @ router_w + router_b).astype(jnp.float32)
    top_logit, top_idx = lax.top_k(logits, TOP_K)
    top_w = jax.nn.softmax(top_logit, axis=-1)
    e_flat = top_idx.reshape(n_assign)
    t_flat = jnp.arange(n_assign, dtype=jnp.int32) // TOP_K
    w_flat = top_w.reshape(n_assign)
    order = jnp.argsort(e_flat)
    e_sorted = e_flat[order]
    counts = jnp.bincount(e_flat, length=N_EXPERTS)
    starts = jnp.cumsum(counts) - counts
    padded = (counts + MOE_BLOCK - 1) // MOE_BLOCK * MOE_BLOCK
    pad_end = jnp.cumsum(padded)
    pad_start = pad_end - padded
    dest = pad_start[e_sorted] + jnp.arange(n_assign, dtype=jnp.int32) - starts[e_sorted]
    row_tok = jnp.full((n_blocks * MOE_BLOCK,), n_tok, jnp.int32).at[dest].set(t_flat[order])
    row_w = jnp.zeros((n_blocks * MOE_BLOCK,), jnp.float32).at[dest].set(w_flat[order])
    block_expert = jnp.minimum(
        jnp.searchsorted(pad_end, jnp.arange(n_blocks, dtype=jnp.int32) * MOE_BLOCK, side='right'),
        N_EXPERTS - 1)
    x_pad = jnp.concatenate([xt, jnp.zeros((1, d), xt.dtype)], axis=0)

    def expert_block(acc, blk):
        tok, wt, e = blk
        xb = x_pad[tok]
        act = clamped_swiglu(xb @ w_gate[e] + b_gate[e], xb @ w_up[e] + b_up[e])
        yb = act @ w_down[e] + b_down[e]
        return acc.at[tok].add(wt[:, None].astype(yb.dtype) * yb), None

    acc, _ = lax.scan(expert_block, jnp.zeros((n_tok + 1, d), xt.dtype),
                      (row_tok.reshape(n_blocks, MOE_BLOCK), row_w.reshape(n_blocks, MOE_BLOCK), block_expert))
    return acc[:n_tok].reshape(bsz, seq, d)


def hybrid_layer(x, c, w_ada, b_ada, w_in, b_in, dw_w, dw_b, conv_ln_g, conv_ln_b, mh_g, w_out,
                 ln1_g, ln1_b, router_w, router_b, w_gate, b_gate, w_up, b_up, w_down, b_down, ln2_g, ln2_b):
    bsz, seq, _ = x.shape
    mod = jax.nn.silu(c) @ w_ada + b_ada
    sh1, sc1, g1, sh2, sc2, g2 = jnp.split(mod[:, None, :], 6, axis=-1)
    h = layer_norm(x) * (1.0 + sc1) + sh1
    z = h @ w_in + b_in
    a_c, g_c, q, k, v, o, ig, fg = jnp.split(z, SPLIT_POINTS, axis=-1)
    y_conv = conformer_conv(a_c, g_c, dw_w, dw_b, conv_ln_g, conv_ln_b)
    hm = mlstm_chunkwise(q.reshape(bsz, seq, MLSTM_HEADS, DK), k.reshape(bsz, seq, MLSTM_HEADS, DK),
                         v.reshape(bsz, seq, MLSTM_HEADS, DV), ig, fg)
    hm = hm * lax.rsqrt(jnp.mean(jnp.square(hm), axis=-1, keepdims=True) + LN_EPS)
    hm = hm * mh_g.reshape(MLSTM_HEADS, DV).astype(jnp.float32)
    y_mlstm = (hm.reshape(bsz, seq, D_MLSTM) * jax.nn.sigmoid(o.astype(jnp.float32))).astype(x.dtype)
    y_mix = jnp.concatenate([y_conv, y_mlstm], axis=-1) @ w_out
    x = layer_norm(DEEPNORM_ALPHA * x + g1 * y_mix, ln1_g, ln1_b)
    h2 = layer_norm(x) * (1.0 + sc2) + sh2
    y_moe = moe_ffn(h2, router_w, router_b, w_gate, b_gate, w_up, b_up, w_down, b_down)
    return layer_norm(DEEPNORM_ALPHA * x + g2 * y_moe, ln2_g, ln2_b)


def setup_inputs(seed: int = 0) -> dict:
    key = jax.random.key(seed)
    ks = jax.random.split(key, 24)

    def nrm(k, shape, scale):
        return jax.random.normal(k, shape, jnp.float32) * scale

    b_in = nrm(ks[5], (DEPTH, D_IN), 0.01)
    b_in = b_in.at[:, D_IN - MLSTM_HEADS:].add(jnp.linspace(3.0, 6.0, MLSTM_HEADS))
    return {
        'x': nrm(ks[0], (BATCH, SEQ, D_MODEL), 1.0),
        'c': nrm(ks[1], (BATCH, D_MODEL), 1.0),
        'w_ada': nrm(ks[2], (DEPTH, D_MODEL, 6 * D_MODEL), D_MODEL ** -0.5),
        'b_ada': nrm(ks[3], (DEPTH, 6 * D_MODEL), 0.01),
        'w_in': nrm(ks[4], (DEPTH, D_MODEL, D_IN), D_MODEL ** -0.5),
        'b_in': b_in,
        'dw_w': nrm(ks[6], (DEPTH, CONV_WIDTH, D_CONV), CONV_WIDTH ** -0.5),
        'dw_b': nrm(ks[7], (DEPTH, D_CONV), 0.01),
        'conv_ln_g': 1.0 + nrm(ks[8], (DEPTH, D_CONV), 0.01),
        'conv_ln_b': nrm(ks[9], (DEPTH, D_CONV), 0.01),
        'mh_g': 1.0 + nrm(ks[10], (DEPTH, D_MLSTM), 0.01),
        'w_out': nrm(ks[11], (DEPTH, D_MIX, D_MODEL), D_MIX ** -0.5 * DEEPNORM_BETA),
        'ln1_g': 1.0 + nrm(ks[12], (DEPTH, D_MODEL), 0.01),
        'ln1_b': nrm(ks[13], (DEPTH, D_MODEL), 0.01),
        'router_w': nrm(ks[14], (DEPTH, D_MODEL, N_EXPERTS), D_MODEL ** -0.5),
        'router_b': nrm(ks[15], (DEPTH, N_EXPERTS), 0.01),
        'w_gate': nrm(ks[16], (DEPTH, N_EXPERTS, D_MODEL, D_EXPERT), D_MODEL ** -0.5),
        'b_gate': nrm(ks[17], (DEPTH, N_EXPERTS, D_EXPERT), 0.01),
        'w_up': nrm(ks[18], (DEPTH, N_EXPERTS, D_MODEL, D_EXPERT), D_MODEL ** -0.5),
        'b_up': nrm(ks[19], (DEPTH, N_EXPERTS, D_EXPERT), 0.01),
        'w_down': nrm(ks[20], (DEPTH, N_EXPERTS, D_EXPERT, D_MODEL), D_EXPERT ** -0.5 * DEEPNORM_BETA),
        'b_down': nrm(ks[21], (DEPTH, N_EXPERTS, D_MODEL), 0.01 * DEEPNORM_BETA),
        'ln2_g': 1.0 + nrm(ks[22], (DEPTH, D_MODEL), 0.01),
        'ln2_b': nrm(ks[23], (DEPTH, D_MODEL), 0.01),
    }


def reference(x, c, w_ada, b_ada, w_in, b_in, dw_w, dw_b, conv_ln_g, conv_ln_b, mh_g, w_out,
              ln1_g, ln1_b, router_w, router_b, w_gate, b_gate, w_up, b_up, w_down, b_down, ln2_g, ln2_b):
    for l in range(DEPTH):
        x = hybrid_layer(x, c, w_ada[l], b_ada[l], w_in[l], b_in[l], dw_w[l], dw_b[l], conv_ln_g[l], conv_ln_b[l],
                         mh_g[l], w_out[l], ln1_g[l], ln1_b[l], router_w[l], router_b[l], w_gate[l], b_gate[l],
                         w_up[l], b_up[l], w_down[l], b_down[l], ln2_g[l], ln2_b[l])
    return x
```

```cpp
#include <hip/hip_runtime.h>
#include <cstdio>
#include <cstdint>

#define LAS __attribute__((address_space(3)))
typedef unsigned short bf16_t;
typedef short bf16x8 __attribute__((ext_vector_type(8)));
typedef short s16x4 __attribute__((ext_vector_type(4)));
typedef short v4i16_t __attribute__((ext_vector_type(4)));
typedef float f32x4 __attribute__((ext_vector_type(4)));
typedef float f32x2 __attribute__((ext_vector_type(2)));
typedef unsigned u32x4 __attribute__((ext_vector_type(4)));
typedef unsigned u32x2 __attribute__((ext_vector_type(2)));

constexpr int D = 2048, BATCH = 8, SEQ = 4096, T = BATCH * SEQ;
constexpr int ZW = 4096;
constexpr int DIN = 5128, DINP = 5120;
constexpr int NE = 32;
constexpr float LN_EPS = 1e-5f;
constexpr float ALPHA = 1.189207115002721f;
constexpr float KSCALE = 0.08838834764831845f;
constexpr int MAXTILES = 544;
constexpr int NPH = 11;

constexpr size_t MiB = 1u << 20;
constexpr size_t WS_CTL = 0, CTL_ZERO_BYTES = 1 * MiB;
constexpr size_t WS_MOD = 1 * MiB;
constexpr size_t WS_GATES = 2 * MiB;
constexpr size_t WS_WRT = 3 * MiB;
constexpr size_t WS_TOKE = 4 * MiB;
constexpr size_t WS_TOKW = 5 * MiB;
constexpr size_t WS_TOKP = 6 * MiB;
constexpr size_t WS_WGCNT = 7 * MiB;
constexpr size_t WS_ROWTOK = 8 * MiB;
constexpr size_t WS_TILEE = 9 * MiB;
constexpr size_t WS_WTIN = 16 * MiB;
constexpr size_t WS_WTOUT = 36 * MiB;
constexpr size_t WS_WTIN8 = 40 * MiB;
constexpr size_t WS_HF8 = 560 * MiB;
constexpr size_t WS_WTGU = 48 * MiB;
constexpr size_t WS_WTDN = 304 * MiB;
constexpr size_t WS_H = 432 * MiB;
constexpr size_t WS_H8 = 432 * MiB;
constexpr size_t WS_STAT = 560 * MiB;
constexpr size_t WS_Z = 816 * MiB;
constexpr size_t WS_YMIX = 1136 * MiB;
constexpr size_t WS_HBUF = 1264 * MiB;
constexpr size_t WS_R = 624 * MiB;
constexpr size_t WS_ACT = 816 * MiB;
constexpr size_t WS_YB = 1088 * MiB;
constexpr size_t WS_SCAL = 1632 * MiB;
constexpr size_t WS_END = 1664 * MiB;
static_assert(WS_ACT + (size_t)MAXTILES * 256 * 2048 <= WS_YB && WS_YB + (size_t)MAXTILES * 256 * 2048 * 2 <= WS_END, "overlay map");
constexpr int SCALE_ONE = 0x7F7F7F7F, SCALE_W = 0x79797979, SCALE_ACT = 0x7D7D7D7D, SCALE_ACT8 = 0x80808080;
constexpr int CW_BAR = 4096;

constexpr int LDS_BYTES = 147456;
constexpr int MISC_OFF = 131072 + 8192 + 4096;

typedef __bf16 bf16x2_t __attribute__((ext_vector_type(2)));
__device__ __forceinline__ unsigned cvt_pk_bf16(float lo, float hi) { const f32x2 v = {lo, hi}; const bf16x2_t b = __builtin_convertvector(v, bf16x2_t); return __builtin_bit_cast(unsigned, b); }
__device__ __forceinline__ unsigned cvt4_fp8(float a, float b, float c, float d) { int r = __builtin_amdgcn_cvt_pk_fp8_f32(a, b, 0, false); r = __builtin_amdgcn_cvt_pk_fp8_f32(c, d, r, true); return (unsigned)r; }
__device__ __forceinline__ float bf_lo(unsigned u) { return __uint_as_float(u << 16); }
__device__ __forceinline__ float bf_hi(unsigned u) { return __uint_as_float(u & 0xffff0000u); }
__device__ __forceinline__ float dpp_add(float v, const int ctrl_sel) {
    int r;
    if (ctrl_sel == 0) r = __builtin_amdgcn_update_dpp(0, __float_as_int(v), 0xB1, 0xF, 0xF, true);
    else if (ctrl_sel == 1) r = __builtin_amdgcn_update_dpp(0, __float_as_int(v), 0x4E, 0xF, 0xF, true);
    else if (ctrl_sel == 2) r = __builtin_amdgcn_update_dpp(0, __float_as_int(v), 0x141, 0xF, 0xF, true);
    else r = __builtin_amdgcn_update_dpp(0, __float_as_int(v), 0x140, 0xF, 0xF, true);
    return v + __int_as_float(r);
}
__device__ __forceinline__ float row16_sum(float v) { v = dpp_add(v, 0); v = dpp_add(v, 1); v = dpp_add(v, 2); v = dpp_add(v, 3); return v; }
__device__ __forceinline__ float wave_sum(float v) {
    v = row16_sum(v);
    { const auto r = __builtin_amdgcn_permlane16_swap(__float_as_uint(v), __float_as_uint(v), false, false); v = __uint_as_float(r[0]) + __uint_as_float(r[1]); }
    { const auto r = __builtin_amdgcn_permlane32_swap(__float_as_uint(v), __float_as_uint(v), false, false); v = __uint_as_float(r[0]) + __uint_as_float(r[1]); }
    return v;
}
__device__ __forceinline__ float sigmoidf_(float x) { return __builtin_amdgcn_rcpf(1.0f + __builtin_amdgcn_exp2f(x * -1.4426950408889634f)); }
#define LDS_WAIT() asm volatile("s_waitcnt lgkmcnt(0)" ::: "memory")

namespace pg8 {
constexpr int BM = 256, BK = 64, HALF = 128, HTB = HALF * BK * 2, STAGE_BYTES = 8 * HTB, NXCD = 8, WGM = 8;
__host__ __device__ __forceinline__ int lds_byte(int r, int c) { const int st = (r >> 4) * 2 + (c >> 5), rr = r & 15, cc = c & 31, ob = rr * 64 + cc * 2; return st * 1024 + (ob ^ (((ob >> 9) & 1) << 5)); }
__host__ __device__ __forceinline__ void stage_rc(int b, int& R, int& C) { const int st = b / 1024, sb = b % 1024, swz = sb ^ (((sb >> 9) & 1) << 5); R = (st >> 1) * 16 + swz / 64; C = (st & 1) * 32 + (swz % 64) / 2; }
__host__ __device__ __forceinline__ int perm32(int rho) { const int n = rho >> 4, i = rho & 15; return 8 * (i >> 2) + 4 * n + (i & 3); }

typedef int i32x4 __attribute__((ext_vector_type(4)));
typedef int i32x8 __attribute__((ext_vector_type(8)));
__device__ __forceinline__ i32x8 cat_i8(bf16x8 a, bf16x8 b) { return __builtin_shufflevector(__builtin_bit_cast(i32x4, a), __builtin_bit_cast(i32x4, b), 0, 1, 2, 3, 4, 5, 6, 7); }
__device__ __forceinline__ void mfma8(f32x4& acc, i32x8 a, i32x8 b, int sa, int sb) {
    asm volatile("v_mfma_scale_f32_16x16x128_f8f6f4 %0, %1, %2, %0, %3, %4 op_sel_hi:[0,0,0]" : "+a"(acc) : "v"(a), "v"(b), "v"(sa), "v"(sb));
}
__device__ __forceinline__ void mfma16a(f32x4& acc, bf16x8 a, bf16x8 b) { asm volatile("v_mfma_f32_16x16x32_bf16 %0, %1, %2, %0" : "+a"(acc) : "v"(a), "v"(b)); }
__device__ __forceinline__ void acc_settle(f32x4 (&acc)[2][2][4][2]) {
#pragma unroll
    for (int a = 0; a < 2; ++a)
#pragma unroll
        for (int b = 0; b < 2; ++b)
            asm volatile("s_nop 15\n\ts_nop 7" : "+a"(acc[a][b][0][0]), "+a"(acc[a][b][0][1]), "+a"(acc[a][b][1][0]), "+a"(acc[a][b][1][1]), "+a"(acc[a][b][2][0]), "+a"(acc[a][b][2][1]), "+a"(acc[a][b][3][0]), "+a"(acc[a][b][3][1]));
}
template <int OFF> __device__ __forceinline__ int aload1(const int* sbase, unsigned voff) { int v; asm volatile("global_load_dword %0, %1, %2 offset:%3" : "=&v"(v) : "v"(voff), "s"(sbase), "n"(OFF) : "memory"); return v; }
template <int OFF> __device__ __forceinline__ f32x4 aload4(const float* sbase, unsigned voff) { f32x4 v; asm volatile("global_load_dwordx4 %0, %1, %2 offset:%3" : "=&v"(v) : "v"(voff), "s"(sbase), "n"(OFF) : "memory"); return v; }
struct Unit { int pm, pn, e; };
struct TileOrder {
    int nM, nN, nwg, G, c;
    __device__ void init(int nM_, int nN_, int G_, int c_) { nM = nM_; nN = nN_; nwg = nM * nN; G = G_; c = c_; }
    __device__ bool next(int i, Unit& u) const {
        const long L = (long)i * G + c; if (L >= nwg) return false;
        int wgid = (int)L; { const int q = nwg / NXCD, r = nwg % NXCD, xcd = wgid % NXCD, off = wgid / NXCD; wgid = (xcd < r ? xcd * (q + 1) : r * (q + 1) + (xcd - r) * q) + off; }
        const int nig = WGM * nN, gid = wgid / nig, fm = gid * WGM, gsz = (nM - fm) < WGM ? (nM - fm) : WGM;
        u.pm = __builtin_amdgcn_readfirstlane(fm + ((wgid % nig) % gsz)); u.pn = __builtin_amdgcn_readfirstlane((wgid % nig) / gsz); return true;
    }
};
struct ProbPlain {
    static constexpr bool GATHER = false, FP8 = false;
    const unsigned char* A; const unsigned char* Bt; int KB;
    __device__ __forceinline__ const char* a_base(const Unit& u) const { return (const char*)(A + (size_t)u.pm * BM * KB); }
    __device__ __forceinline__ const char* b_base(const Unit& u) const { return (const char*)(Bt + (size_t)u.pn * BM * KB); }
    static constexpr bool EXPERT = false;
    __device__ __forceinline__ int raw_e(const Unit&) const { return 0; }
    __device__ __forceinline__ const int* e_ptr(const Unit&) const { return nullptr; }
    __device__ __forceinline__ int raw_tok(const Unit&, int) const { return 0; }
    __device__ __forceinline__ const int* tok_base(const Unit&) const { return nullptr; }
    __device__ __forceinline__ int sa() const { return 0; }
    __device__ __forceinline__ int sb() const { return 0; }
};
struct ProbPlain8 {
    static constexpr bool GATHER = false, FP8 = true;
    const unsigned char* A; const unsigned char* Bt; int KB; int scale_a, scale_b;
    __device__ __forceinline__ const char* a_base(const Unit& u) const { return (const char*)(A + (size_t)u.pm * BM * KB); }
    __device__ __forceinline__ const char* b_base(const Unit& u) const { return (const char*)(Bt + (size_t)u.pn * BM * KB); }
    static constexpr bool EXPERT = false;
    __device__ __forceinline__ int raw_e(const Unit&) const { return 0; }
    __device__ __forceinline__ const int* e_ptr(const Unit&) const { return nullptr; }
    __device__ __forceinline__ int raw_tok(const Unit&, int) const { return 0; }
    __device__ __forceinline__ const int* tok_base(const Unit&) const { return nullptr; }
    __device__ __forceinline__ int sa() const { return scale_a; }
    __device__ __forceinline__ int sb() const { return scale_b; }
};
struct ProbExpert {
    static constexpr bool GATHER = false, FP8 = true;
    const unsigned char* A; const unsigned char* Bt; int KB; int nrows_e; const int* tile_e; int scale_a, scale_b;
    __device__ __forceinline__ const char* a_base(const Unit& u) const { return (const char*)(A + (size_t)u.pm * BM * KB); }
    __device__ __forceinline__ const char* b_base(const Unit& u) const { return (const char*)(Bt + ((size_t)u.e * nrows_e + (size_t)u.pn * BM) * KB); }
    static constexpr bool EXPERT = true;
    __device__ __forceinline__ int raw_e(const Unit& u) const { return tile_e[u.pm]; }
    __device__ __forceinline__ const int* e_ptr(const Unit& u) const { return tile_e + u.pm; }
    __device__ __forceinline__ int raw_tok(const Unit&, int) const { return 0; }
    __device__ __forceinline__ const int* tok_base(const Unit&) const { return nullptr; }
    __device__ __forceinline__ int sa() const { return scale_a; }
    __device__ __forceinline__ int sb() const { return scale_b; }
};
struct ProbGather {
    static constexpr bool GATHER = true, FP8 = true;
    const unsigned char* A; const unsigned char* Bt; int KB; int nrows_e; const int* tile_e; const int* row_tok; int scale_a, scale_b;
    __device__ __forceinline__ const char* a_base(const Unit&) const { return (const char*)A; }
    __device__ __forceinline__ const char* b_base(const Unit& u) const { return (const char*)(Bt + ((size_t)u.e * nrows_e + (size_t)u.pn * BM) * KB); }
    static constexpr bool EXPERT = true;
    __device__ __forceinline__ int raw_e(const Unit& u) const { return tile_e[u.pm]; }
    __device__ __forceinline__ const int* e_ptr(const Unit& u) const { return tile_e + u.pm; }
    __device__ __forceinline__ int raw_tok(const Unit& u, int r) const { return row_tok[u.pm * BM + r]; }
    __device__ __forceinline__ const int* tok_base(const Unit& u) const { return row_tok + u.pm * BM; }
    __device__ __forceinline__ int sa() const { return scale_a; }
    __device__ __forceinline__ int sb() const { return scale_b; }
};

template <class Epi, class Prob>
__device__ __forceinline__ void gemm_phase(LAS unsigned char* lds, const Prob& P, const TileOrder& S, const Epi& E, const int tid) {
    const int wid = __builtin_amdgcn_readfirstlane(tid >> 6), lane = tid & 63, wr = wid >> 2, wc = wid & 3, fr = lane & 15, fq = lane >> 4;
    const int KB = P.KB, nt = KB / 128;
    unsigned voffB[2], vc0[2], vc1[2], vn0[2], vn1[2]; int RA[2], CA[2];
    const size_t kstep = 128;
    const size_t hstep = (size_t)HALF * KB;
    const size_t bstep = Epi::PERM == 2 ? (size_t)32 * KB : hstep;
    const int sA = P.sa(), sB = P.sb(); (void)sA; (void)sB;
#pragma unroll
    for (int i = 0; i < 2; ++i) { int R, C; stage_rc(tid * 16 + i * 8192, R, C); const int Rb = Epi::PERM == 2 ? (64 * (R >> 5) + perm32(R & 31)) : Epi::PERM ? ((R & ~31) + perm32(R & 31)) : R;
        RA[i] = R; CA[i] = C; voffB[i] = (unsigned)(Rb * KB + C * 2);
        if constexpr (!Prob::GATHER) { vc0[i] = (unsigned)(R * KB + C * 2); vc1[i] = vc0[i] + (unsigned)hstep; vn0[i] = vc0[i]; vn1[i] = vc1[i]; } }
    const unsigned ldsw = (unsigned)wid * 1024u;
    const int aoff = lds_byte(wr * 64 + fr, fq * 8), boff = lds_byte(wc * 32 + fr, fq * 8);
#define PG8_SA(b, h) (((b) * 2 + (h)) * HTB)
#define PG8_SB(b, h) ((4 + (b) * 2 + (h)) * HTB)
#define PG8_STAGE(bufoff, gbase, voff) do { _Pragma("unroll") for (int _i = 0; _i < 2; ++_i) \
        __builtin_amdgcn_global_load_lds((const unsigned*)((const char*)(gbase) + (voff)[_i]), (LAS unsigned*)(lds + (bufoff) + ldsw + _i * 8192), 16, 0, 0); } while (0)
#define PG8_LDA(dst, b, h) do { _Pragma("unroll") for (int m = 0; m < 4; ++m) _Pragma("unroll") for (int k = 0; k < 2; ++k) dst[m][k] = *(const LAS bf16x8*)(lds + PG8_SA(b, h) + aoff + m * 2048 + k * 1024); } while (0)
#define PG8_LDB(dst, b, h) do { _Pragma("unroll") for (int n = 0; n < 2; ++n) _Pragma("unroll") for (int k = 0; k < 2; ++k) dst[n][k] = *(const LAS bf16x8*)(lds + PG8_SB(b, h) + boff + n * 2048 + k * 1024); } while (0)
#define PG8_MMA(ai, bj, At, Bt) do { __builtin_amdgcn_s_setprio(1); _Pragma("unroll") for (int m = 0; m < 4; ++m) _Pragma("unroll") for (int n = 0; n < 2; ++n) { \
        if constexpr (Prob::FP8) mfma8(acc[ai][bj][m][n], cat_i8(Bt[n][0], Bt[n][1]), cat_i8(At[m][0], At[m][1]), sB, sA); \
        else { _Pragma("unroll") for (int k = 0; k < 2; ++k) mfma16a(acc[ai][bj][m][n], Bt[n][k], At[m][k]); } } __builtin_amdgcn_s_setprio(0); } while (0)
#define PG8_WAIT_V(n) asm volatile("s_waitcnt vmcnt(" #n ")" ::: "memory")
#define PG8_WAIT_L(n) asm volatile("s_waitcnt lgkmcnt(" #n ")" ::: "memory")
#define PG8_BAR __builtin_amdgcn_s_barrier()
#define PG8_SCHED __builtin_amdgcn_sched_barrier(0)
    Unit cur, nxt, nx2; int ui = 0;
    if (!S.next(0, cur)) return;
    bool has_next = S.next(1, nxt);
    cur.e = __builtin_amdgcn_readfirstlane(P.raw_e(cur)); nxt.e = has_next ? __builtin_amdgcn_readfirstlane(P.raw_e(nxt)) : 0; nx2.e = 0;
    f32x4 acc[2][2][4][2]; f32x4 nb[2][2];
#pragma unroll
    for (int b = 0; b < 2; ++b)
#pragma unroll
        for (int n = 0; n < 2; ++n) { if constexpr (Epi::BIAS) nb[b][n] = *(const f32x4*)(E.bias_base(cur, wc, b) + 8 * fq + 4 * n); else nb[b][n] = (f32x4){0.f, 0.f, 0.f, 0.f}; }
#pragma unroll
    for (int a = 0; a < 2; ++a)
#pragma unroll
        for (int b = 0; b < 2; ++b)
#pragma unroll
            for (int m = 0; m < 4; ++m)
#pragma unroll
                for (int n = 0; n < 2; ++n) { if constexpr (Epi::BIAS) acc[a][b][m][n] = E.bias_xf(nb[b][n], b); else acc[a][b][m][n] = (f32x4){0.f, 0.f, 0.f, 0.f}; }
    bf16x8 At[4][2], B0[2][2], B1[2][2];
    const char* cA = P.a_base(cur); const char* cB = P.b_base(cur);
    if constexpr (Prob::GATHER) {
#pragma unroll
        for (int i = 0; i < 2; ++i) { vc0[i] = (unsigned)P.raw_tok(cur, RA[i]) * (unsigned)KB + (unsigned)CA[i] * 2u; vc1[i] = (unsigned)P.raw_tok(cur, HALF + RA[i]) * (unsigned)KB + (unsigned)CA[i] * 2u; }
    }
    PG8_STAGE(PG8_SB(0, 0), cB, voffB); PG8_STAGE(PG8_SB(0, 1), cB + bstep, voffB); PG8_STAGE(PG8_SA(0, 0), cA, vc0); PG8_STAGE(PG8_SA(0, 1), cA, vc1);
    if (wr == 1) PG8_BAR;
    PG8_WAIT_V(2); PG8_BAR;
    PG8_STAGE(PG8_SB(1, 0), cB + kstep, voffB); PG8_STAGE(PG8_SA(1, 0), cA + kstep, vc0); PG8_STAGE(PG8_SB(1, 1), cB + bstep + kstep, voffB);
    PG8_WAIT_V(6); PG8_BAR;
    int env = 0;
    for (;;) {
        const bool has2 = has_next && S.next(ui + 2, nx2);
        if constexpr (Prob::EXPERT) { if (has2) env = aload1<0>(P.e_ptr(nx2), 0u); }
        int rt0[2] = {0, 0}, rt1[2] = {0, 0};
        if constexpr (Prob::GATHER) { if (has_next) {
#pragma unroll
            for (int i = 0; i < 2; ++i) { rt0[i] = aload1<0>(P.tok_base(nxt), (unsigned)RA[i] * 4u); rt1[i] = aload1<HALF * 4>(P.tok_base(nxt), (unsigned)RA[i] * 4u); } } }
        if constexpr (Epi::BIAS) { if (has_next) { int l_; asm volatile("v_mbcnt_lo_u32_b32 %0, -1, 0\n\tv_mbcnt_hi_u32_b32 %0, -1, %0" : "=v"(l_));
#pragma unroll
            for (int b = 0; b < 2; ++b) { const float* bb = E.bias_base(nxt, wc, b); nb[b][0] = aload4<0>(bb, (unsigned)(l_ >> 4) * 32u); nb[b][1] = aload4<16>(bb, (unsigned)(l_ >> 4) * 32u); } } }
        const char* nA = has_next ? P.a_base(nxt) : cA; const char* nB = has_next ? P.b_base(nxt) : cB;
        for (int t = 0; t < nt; t += 2) {
            const bool last = (t == nt - 2);
            const char* a1 = cA + (size_t)(t + 1) * kstep;
            unsigned x0[2] = {vc0[0], vc0[1]}, x1[2] = {vc1[0], vc1[1]};
            if (last) {
                if constexpr (Prob::GATHER) {
                    if (has_next) {
                        asm volatile("; next unit's rows" : "+v"(rt0[0]), "+v"(rt0[1]), "+v"(rt1[0]), "+v"(rt1[1]));
#pragma unroll
                        for (int i = 0; i < 2; ++i) { vn0[i] = (unsigned)rt0[i] * (unsigned)KB + (unsigned)CA[i] * 2u; vn1[i] = (unsigned)rt1[i] * (unsigned)KB + (unsigned)CA[i] * 2u; }
                    } else {
#pragma unroll
                        for (int i = 0; i < 2; ++i) { vn0[i] = vc0[i]; vn1[i] = vc1[i]; }
                    }
                    x0[0] = vn0[0]; x0[1] = vn0[1]; x1[0] = vn1[0]; x1[1] = vn1[1];
                }
            }
            const char* a2 = last ? nA : cA + (size_t)(t + 2) * kstep; const char* b2 = last ? nB : cB + (size_t)(t + 2) * kstep;
            const char* a3 = a2 + kstep; const char* b3 = b2 + kstep;
            PG8_LDB(B0, 0, 0); PG8_LDB(B1, 0, 1); PG8_SCHED; PG8_LDA(At, 0, 0); PG8_STAGE(PG8_SA(1, 1), a1, vc1);
            PG8_WAIT_V(8); PG8_WAIT_L(0); PG8_BAR; PG8_MMA(0, 0, At, B0); PG8_MMA(0, 1, At, B1); PG8_BAR; PG8_SCHED;
            PG8_LDA(At, 0, 1); PG8_STAGE(PG8_SB(0, 0), b2, voffB); PG8_STAGE(PG8_SB(0, 1), b2 + bstep, voffB); PG8_STAGE(PG8_SA(0, 0), a2, x0);
            PG8_WAIT_V(8); PG8_WAIT_L(0); PG8_BAR; PG8_MMA(1, 0, At, B0); PG8_MMA(1, 1, At, B1); PG8_BAR; PG8_SCHED;
            PG8_LDB(B0, 1, 0); PG8_LDB(B1, 1, 1); PG8_SCHED; PG8_LDA(At, 1, 0); PG8_STAGE(PG8_SA(0, 1), a2, x1);
            PG8_WAIT_V(8); PG8_WAIT_L(0); PG8_BAR; PG8_MMA(0, 0, At, B0); PG8_MMA(0, 1, At, B1); PG8_BAR; PG8_SCHED;
            PG8_LDA(At, 1, 1); PG8_STAGE(PG8_SB(1, 0), b3, voffB); PG8_STAGE(PG8_SB(1, 1), b3 + bstep, voffB); PG8_STAGE(PG8_SA(1, 0), a3, x0);
            PG8_WAIT_V(8); PG8_WAIT_L(0); PG8_BAR; PG8_MMA(1, 0, At, B0); PG8_MMA(1, 1, At, B1); PG8_BAR; PG8_SCHED;
        }
        if (wr == 0) PG8_BAR;
        acc_settle(acc);
        { int l_; asm volatile("v_mbcnt_lo_u32_b32 %0, -1, 0\n\tv_mbcnt_hi_u32_b32 %0, -1, %0" : "=v"(l_)); E(acc, cur, wr, wc, l_ & 15, l_ >> 4); }
        if (!has_next) break;
        asm volatile("; next unit's accumulator init" : "+v"(nb[0][0]), "+v"(nb[0][1]), "+v"(nb[1][0]), "+v"(nb[1][1]), "+v"(env));
#pragma unroll
        for (int a = 0; a < 2; ++a)
#pragma unroll
            for (int b = 0; b < 2; ++b)
#pragma unroll
                for (int m = 0; m < 4; ++m)
#pragma unroll
                    for (int n = 0; n < 2; ++n) { if constexpr (Epi::BIAS) acc[a][b][m][n] = E.bias_xf(nb[b][n], b); else acc[a][b][m][n] = (f32x4){0.f, 0.f, 0.f, 0.f}; }
        cur = nxt; nxt = nx2; has_next = has2; cA = nA; cB = nB; ++ui;
        if constexpr (Prob::EXPERT) { if (has2) nxt.e = __builtin_amdgcn_readfirstlane(env); }
#pragma unroll
        for (int i = 0; i < 2; ++i) { vc0[i] = vn0[i]; vc1[i] = vn1[i]; }
        if (wr == 1) PG8_BAR;
    }
    PG8_WAIT_V(0);
    PG8_BAR;
#undef PG8_SA
#undef PG8_SB
#undef PG8_STAGE
#undef PG8_LDA
#undef PG8_LDB
#undef PG8_MMA
#undef PG8_WAIT_V
#undef PG8_WAIT_L
#undef PG8_BAR
#undef PG8_SCHED
}

struct EpiGLU {
    static constexpr int PERM = 1; static constexpr bool BIAS = true;
    bf16_t* O; const float* bias;
    __device__ __forceinline__ const float* bias_base(const Unit& u, int wc, int bj) const { return bias + bj * 1024 + u.pn * HALF + wc * 32; }
    __device__ __forceinline__ f32x4 bias_xf(f32x4 v, int) const { return v; }
    __device__ __forceinline__ void operator()(const f32x4 (&acc)[2][2][4][2], const Unit& u, int wr, int wc, int fr, int fq) const {
        const int row0 = u.pm * BM + wr * 64 + fr, col0 = u.pn * HALF + wc * 32 + 8 * fq;
#pragma unroll
        for (int ai = 0; ai < 2; ++ai)
#pragma unroll
            for (int m = 0; m < 4; ++m) { bf16_t* rowp = O + (size_t)(row0 + ai * HALF + m * 16) * ZW + col0;
                float o[8];
#pragma unroll
                for (int n = 0; n < 2; ++n) { const f32x4 av = acc[ai][0][m][n], gv = acc[ai][1][m][n];
#pragma unroll
                    for (int j = 0; j < 4; ++j) o[4 * n + j] = av[j] * __builtin_amdgcn_rcpf(1.0f + __builtin_amdgcn_exp2f(gv[j] * -1.4426950408889634f)); }
                u32x4 w; w.x = cvt_pk_bf16(o[0], o[1]); w.y = cvt_pk_bf16(o[2], o[3]); w.z = cvt_pk_bf16(o[4], o[5]); w.w = cvt_pk_bf16(o[6], o[7]);
                *(u32x4*)rowp = w; }
    }
};
struct EpiZ {
    static constexpr int PERM = 1; static constexpr bool BIAS = true;
    bf16_t* O; const float* bias; int zcol0, bcol0, ks0;
    __device__ __forceinline__ const float* bias_base(const Unit& u, int wc, int bj) const { return bias + bcol0 + u.pn * BM + wc * 32 + bj * HALF; }
    __device__ __forceinline__ f32x4 bias_xf(f32x4 v, int) const { return v; }
    __device__ __forceinline__ void operator()(const f32x4 (&acc)[2][2][4][2], const Unit& u, int wr, int wc, int fr, int fq) const {
        const int row0 = u.pm * BM + wr * 64 + fr, col0 = u.pn * BM + wc * 32 + 8 * fq;
        const float sc = (u.pn == ks0 || u.pn == ks0 + 1) ? KSCALE : 1.0f;
#pragma unroll
        for (int ai = 0; ai < 2; ++ai)
#pragma unroll
            for (int m = 0; m < 4; ++m) { bf16_t* rowp = O + (size_t)(row0 + ai * HALF + m * 16) * ZW + zcol0 + col0;
#pragma unroll
                for (int bj = 0; bj < 2; ++bj) { const f32x4 v0 = acc[ai][bj][m][0] * sc, v1 = acc[ai][bj][m][1] * sc;
                    u32x4 w; w.x = cvt_pk_bf16(v0[0], v0[1]); w.y = cvt_pk_bf16(v0[2], v0[3]); w.z = cvt_pk_bf16(v1[0], v1[1]); w.w = cvt_pk_bf16(v1[2], v1[3]);
                    *(u32x4*)(rowp + bj * HALF) = w; } }
    }
};
struct EpiR {
    static constexpr int PERM = 1; static constexpr bool BIAS = false;
    __device__ __forceinline__ const float* bias_base(const Unit&, int, int) const { return nullptr; }
    __device__ __forceinline__ f32x4 bias_xf(f32x4 v, int) const { return v; }
    bf16_t* R; const float* x; const float* mod;
    __device__ __forceinline__ void operator()(const f32x4 (&acc)[2][2][4][2], const Unit& u, int wr, int wc, int fr, int fq) const {
        const int row0 = u.pm * BM + wr * 64 + fr, col0 = u.pn * BM + wc * 32 + 8 * fq;
        const int b = (u.pm * BM) / SEQ;
        f32x4 gv[2][2];
#pragma unroll
        for (int bj = 0; bj < 2; ++bj)
#pragma unroll
            for (int n = 0; n < 2; ++n) gv[bj][n] = *(const f32x4*)(mod + (size_t)b * 12288 + 4096 + col0 + bj * HALF + 4 * n);
#pragma unroll
        for (int ai = 0; ai < 2; ++ai)
#pragma unroll
            for (int m = 0; m < 4; ++m) { const size_t off = (size_t)(row0 + ai * HALF + m * 16) * D + col0;
#pragma unroll
                for (int bj = 0; bj < 2; ++bj) { const f32x4 x0 = *(const f32x4*)(x + off + bj * HALF), x1v = *(const f32x4*)(x + off + bj * HALF + 4);
                    const f32x4 v0 = x0 * ALPHA + gv[bj][0] * acc[ai][bj][m][0], v1 = x1v * ALPHA + gv[bj][1] * acc[ai][bj][m][1];
                    u32x4 w; w.x = cvt_pk_bf16(v0[0], v0[1]); w.y = cvt_pk_bf16(v0[2], v0[3]); w.z = cvt_pk_bf16(v1[0], v1[1]); w.w = cvt_pk_bf16(v1[2], v1[3]);
                    *(u32x4*)(R + off + bj * HALF) = w; }
                asm volatile("" ::: "memory"); }
    }
};
struct EpiAct {
    static constexpr int PERM = 1; static constexpr bool BIAS = true;
    unsigned char* O; const float* bg; const float* bu; const int* tile_e;
    __device__ __forceinline__ const float* bias_base(const Unit& u, int wc, int bj) const { return (bj ? bu : bg) + (size_t)u.e * D + u.pn * HALF + wc * 32; }
    __device__ __forceinline__ f32x4 bias_xf(f32x4 v, int bj) const { return bj ? v + 1.0f : v; }
    __device__ __forceinline__ void operator()(const f32x4 (&acc)[2][2][4][2], const Unit& u, int wr, int wc, int fr, int fq) const {
        const int row0 = u.pm * BM + wr * 64 + fr;
        const int colw = u.pn * HALF + wc * 32 + 16 * (fq >> 1), rsel = fq & 1;
#pragma unroll
        for (int ai = 0; ai < 2; ++ai)
#pragma unroll
            for (int mp = 0; mp < 2; ++mp) {
                u32x2 w2[2];
#pragma unroll
                for (int h = 0; h < 2; ++h) { const int m = 2 * mp + h; float o[8];
#pragma unroll
                    for (int n = 0; n < 2; ++n) { const f32x4 gt = acc[ai][0][m][n], up = acc[ai][1][m][n];
#pragma unroll
                        for (int j = 0; j < 4; ++j) {
                            const float a = fminf(gt[j], 7.0f), u1 = fminf(fmaxf(up[j], -6.0f), 8.0f);
                            o[4 * n + j] = a * u1 * __builtin_amdgcn_rcpf(__builtin_fmaf(__builtin_amdgcn_exp2f(a * -2.4554669595930156f), 0.25f, 0.25f)); } }
                    w2[h].x = cvt4_fp8(o[0], o[1], o[2], o[3]); w2[h].y = cvt4_fp8(o[4], o[5], o[6], o[7]); }
                const auto rx = __builtin_amdgcn_permlane16_swap(w2[0].x, w2[1].x, false, false), ry = __builtin_amdgcn_permlane16_swap(w2[0].y, w2[1].y, false, false);
                *(u32x4*)(O + (size_t)(row0 + ai * HALF + (2 * mp + rsel) * 16) * D + colw) = (u32x4){rx[0], ry[0], rx[1], ry[1]}; }
    }
};
struct EpiY {
    static constexpr int PERM = 2; static constexpr bool BIAS = true;
    unsigned char* O; const float* bias; const int* tile_e;
    __device__ __forceinline__ const float* bias_base(const Unit& u, int wc, int bj) const { return bias + (size_t)u.e * D + u.pn * BM + wc * 64 + bj * 32; }
    __device__ __forceinline__ f32x4 bias_xf(f32x4 v, int) const { return v * 8.0f; }
    __device__ __forceinline__ void operator()(const f32x4 (&acc)[2][2][4][2], const Unit& u, int wr, int wc, int fr, int fq) const {
        const int row0 = u.pm * BM + wr * 64 + fr;
        const int colw = u.pn * BM + wc * 64 + ((fq & 1) ? 32 + 8 * (fq - 1) : 8 * fq);
#pragma unroll
        for (int ai = 0; ai < 2; ++ai)
#pragma unroll
            for (int m = 0; m < 4; ++m) {
                u32x2 w2[2];
#pragma unroll
                for (int bj = 0; bj < 2; ++bj) { const f32x4 v0 = acc[ai][bj][m][0], v1 = acc[ai][bj][m][1];
                    w2[bj].x = cvt4_fp8(v0[0], v0[1], v0[2], v0[3]); w2[bj].y = cvt4_fp8(v1[0], v1[1], v1[2], v1[3]); }
                const auto rx = __builtin_amdgcn_permlane16_swap(w2[0].x, w2[1].x, false, false), ry = __builtin_amdgcn_permlane16_swap(w2[0].y, w2[1].y, false, false);
                *(u32x4*)(O + (size_t)(row0 + ai * HALF + m * 16) * D + colw) = (u32x4){rx[0], ry[0], rx[1], ry[1]}; }
    }
};
}

#define XB_TMO      128
#define XB_XCNT(j)  (256  + 64 * (j))
#define XB_XSUB(j)  (1280 + 64 * (j))
#define XB_XGEN(j)  (2304 + 64 * (j))
#define XB_TOP      3328
#define XB_TOPGEN   3392
#define XCD_BAR_WORDS 3456
#define XB_SPIN_CAP (1u << 18)
__device__ __forceinline__ unsigned xb_ld(unsigned* p)              { return __hip_atomic_load(p, __ATOMIC_RELAXED, __HIP_MEMORY_SCOPE_AGENT); }
__device__ __forceinline__ unsigned xb_add(unsigned* p, unsigned v) { return __hip_atomic_fetch_add(p, v, __ATOMIC_RELAXED, __HIP_MEMORY_SCOPE_AGENT); }
__device__ __forceinline__ unsigned xb_xcc_id() { return (unsigned)__builtin_amdgcn_s_getreg((3 << 11) | 20) & 0xFu; }
#define XB_SPIN(cond, bar) do { unsigned _sp = 0; while (cond) { __builtin_amdgcn_s_sleep(1); \
    if ((++_sp & 255u) == 0u) { if (xb_ld(&(bar)[XB_TMO])) break; if (_sp > XB_SPIN_CAP) { atomicAdd(&(bar)[XB_TMO], 1u); break; } } } } while (0)
struct XcdBarrier { unsigned* bar; unsigned x; volatile LAS unsigned* st; };
__device__ __forceinline__ XcdBarrier xcd_barrier_post(unsigned* bar, volatile LAS unsigned* st, int tid) {
    XcdBarrier b; b.bar = bar; b.x = xb_xcc_id(); b.st = st;
    if (tid == 0) (void)xb_add(&bar[XB_XCNT(b.x)], 1u);
    return b;
}
__device__ __forceinline__ void xcd_barrier_complete(unsigned* bar, unsigned x, unsigned& nloc, unsigned& nx) {
    const unsigned G = gridDim.x * gridDim.y * gridDim.z;
    unsigned sum, cnt, mine, sp = 0u;
    for (;;) {
        sum = 0u; cnt = 0u; mine = 0u;
#pragma unroll
        for (unsigned j = 0; j < 16; ++j) { const unsigned c = xb_ld(&bar[XB_XCNT(j)]); sum += c; cnt += (c > 0u) ? 1u : 0u; mine = (j == x) ? c : mine; }
        if (sum == G) break;
        __builtin_amdgcn_s_sleep(1);
        if ((++sp & 255u) == 0u) { if (xb_ld(&bar[XB_TMO])) break; if (sp > XB_SPIN_CAP) { atomicAdd(&bar[XB_TMO], 1u); break; } }
    }
    nloc = mine > 0u ? mine : 1u; nx = cnt > 0u ? cnt : 1u;
}
__device__ __forceinline__ void xcd_barrier(const XcdBarrier& b, int tid) {
    asm volatile("s_waitcnt vmcnt(0)" ::: "memory");
    __syncthreads();
    if (tid == 0) {
        unsigned* bar = b.bar;
        __builtin_amdgcn_s_waitcnt(0);
        unsigned nloc = b.st[0], nx = b.st[1];
        if (nloc == 0u) { xcd_barrier_complete(bar, b.x, nloc, nx); b.st[0] = nloc; b.st[1] = nx; }
        const unsigned old = xb_add(&bar[XB_XSUB(b.x)], 1u);
        const unsigned gen = old / nloc;
        if (old + 1u == (gen + 1u) * nloc) {
            __builtin_amdgcn_fence(__ATOMIC_RELEASE, "agent");
            asm volatile("s_waitcnt vmcnt(0)" ::: "memory");
            const unsigned og = xb_add(&bar[XB_TOP], 1u);
            const unsigned tg = og / nx;
            if (og + 1u == (tg + 1u) * nx) xb_add(&bar[XB_TOPGEN], 1u);
            else XB_SPIN(xb_ld(&bar[XB_TOPGEN]) == tg, bar);
            __builtin_amdgcn_fence(__ATOMIC_ACQUIRE, "agent");
            xb_add(&bar[XB_XGEN(b.x)], 1u);
            asm volatile("s_waitcnt vmcnt(0)" ::: "memory");
        } else {
            XB_SPIN(xb_ld(&bar[XB_XGEN(b.x)]) == gen, bar);
            __builtin_amdgcn_fence(__ATOMIC_ACQUIRE, "agent");
            asm volatile("s_waitcnt vmcnt(0)" ::: "memory");
        }
    }
    __syncthreads();
}

struct Args { const float* in[24]; float* out; unsigned char* ws; int ph_lo, ph_hi; };
enum { I_X = 0, I_C, I_WADA, I_BADA, I_WIN, I_BIN, I_DWW, I_DWB, I_CLG, I_CLB, I_MHG, I_WOUT, I_LN1G, I_LN1B, I_RW, I_RB, I_WG, I_BG, I_WU, I_BU, I_WD, I_BD, I_LN2G, I_LN2B };

__device__ __forceinline__ void tr_item(const float* __restrict__ src, int ld, int k0, int n0, bf16_t* dst, size_t drow0, int lane) {
    float v[64];
    const float* sp = src + (size_t)k0 * ld + n0 + lane;
#pragma unroll
    for (int i = 0; i < 64; ++i) v[i] = sp[(size_t)i * ld];
    u32x4* dp = (u32x4*)(dst + (drow0 + lane) * 2048 + k0);
#pragma unroll
    for (int c = 0; c < 8; ++c) { u32x4 o; o.x = cvt_pk_bf16(v[8 * c], v[8 * c + 1]); o.y = cvt_pk_bf16(v[8 * c + 2], v[8 * c + 3]); o.z = cvt_pk_bf16(v[8 * c + 4], v[8 * c + 5]); o.w = cvt_pk_bf16(v[8 * c + 6], v[8 * c + 7]); dp[c] = o; }
}
__device__ __forceinline__ void tr_item8(const float* __restrict__ src, int ld, int k0, int n0, unsigned char* dst, size_t drow0, int lane) {
    float v[64];
    const float* sp = src + (size_t)k0 * ld + n0 + lane;
#pragma unroll
    for (int i = 0; i < 64; ++i) v[i] = sp[(size_t)i * ld] * 64.0f;
    u32x4* dp = (u32x4*)(dst + (drow0 + lane) * 2048 + k0);
#pragma unroll
    for (int c = 0; c < 4; ++c) { u32x4 o; o.x = cvt4_fp8(v[16 * c], v[16 * c + 1], v[16 * c + 2], v[16 * c + 3]); o.y = cvt4_fp8(v[16 * c + 4], v[16 * c + 5], v[16 * c + 6], v[16 * c + 7]);
        o.z = cvt4_fp8(v[16 * c + 8], v[16 * c + 9], v[16 * c + 10], v[16 * c + 11]); o.w = cvt4_fp8(v[16 * c + 12], v[16 * c + 13], v[16 * c + 14], v[16 * c + 15]); dp[c] = o; }
}
__device__ __forceinline__ void phase0(const Args& a, LAS unsigned char* lds, int bid, int G, int tid) {
    const int lane = tid & 63, wave = __builtin_amdgcn_readfirstlane(tid >> 6);
    {
        constexpr int T_IN = 16 * 40, T_SQ = 16 * 16, NTILE = T_IN + T_SQ + 96 * T_SQ;
        const int jq = tid & 7, n_a = tid >> 3;
#define P0_DECODE(t_, src_, ld_, k0_, n0_, kind_, e_) do { int r_ = (t_); \
            if (r_ < T_IN) { n0_ = (r_ % 40) * 128; k0_ = (r_ / 40) * 128; src_ = a.in[I_WIN]; ld_ = DIN; kind_ = 0; e_ = 0; } \
            else { r_ -= T_IN; int mtx_ = 0; if (r_ >= T_SQ) { r_ -= T_SQ; mtx_ = 1 + r_ / T_SQ; r_ = r_ % T_SQ; } \
                n0_ = (r_ & 15) * 128; k0_ = (r_ >> 4) * 128; ld_ = D; \
                if (mtx_ == 0) { src_ = a.in[I_WOUT]; kind_ = 1; e_ = 0; } else { const int m3 = (mtx_ - 1) % 3; e_ = (mtx_ - 1) / 3; kind_ = 2 + m3; \
                    src_ = a.in[m3 == 0 ? I_WG : m3 == 1 ? I_WU : I_WD] + (size_t)e_ * D * D; } } } while (0)
#define P0_ISSUE(t_, buf_) do { const float* src_; int ld_, k0_, n0_, kind_, e_; P0_DECODE(t_, src_, ld_, k0_, n0_, kind_, e_); (void)kind_; (void)e_; \
            _Pragma("unroll") for (int r_ = 0; r_ < 8; ++r_) __builtin_amdgcn_global_load_lds((const unsigned*)(src_ + (size_t)(k0_ + wave * 16 + 2 * r_ + (lane >> 5)) * ld_ + n0_ + 4 * (((lane & 31) + 2 * wave) & 31)), \
                (LAS unsigned*)(lds + (buf_) * 65536 + (wave * 16 + 2 * r_) * 512), 16, 0, 0); } while (0)
        int t = bid, it = 0;
        if (t < NTILE) P0_ISSUE(t, 0);
        for (; t < NTILE; t += G, ++it) {
            const int tn = t + G, cb = it & 1;
            if (tn < NTILE) { P0_ISSUE(tn, cb ^ 1); asm volatile("s_waitcnt vmcnt(8)" ::: "memory"); }
            else asm volatile("s_waitcnt vmcnt(0)" ::: "memory");
            __builtin_amdgcn_s_barrier();
            const float* src; int ld, k0, n0, kind, e; P0_DECODE(t, src, ld, k0, n0, kind, e); (void)src; (void)ld;
            float v[32];
#pragma unroll
            for (int h = 0; h < 2; ++h) { const int n = n_a + 64 * h;
                const LAS float* col = (const LAS float*)(lds + cb * 65536) + (16 * jq) * 128 + 4 * (((n >> 2) - 2 * jq) & 31) + (n & 3);
#pragma unroll
                for (int i = 0; i < 16; ++i) v[16 * h + i] = col[i * 128]; }
#pragma unroll
            for (int h = 0; h < 2; ++h) { const int n = n0 + n_a + 64 * h;
                unsigned char* base; size_t dr;
                if (kind == 0) { base = a.ws + WS_WTIN; dr = n < 1024 ? (size_t)(n >> 7) * 256 + (n & 127) : n < 2048 ? (size_t)((n - 1024) >> 7) * 256 + 128 + (n & 127) : (size_t)n; }
                else if (kind == 1) { base = a.ws + WS_WTOUT; dr = (size_t)n; }
                else if (kind == 4) { base = a.ws + WS_WTDN; dr = (size_t)e * 2048 + n; }
                else { base = a.ws + WS_WTGU; dr = (size_t)e * 4096 + (size_t)(n >> 7) * 256 + (n & 127) + (kind == 3 ? 128 : 0); }
                u32x4 o; const int c = h;
                o.x = cvt4_fp8(v[16 * c] * 64.f, v[16 * c + 1] * 64.f, v[16 * c + 2] * 64.f, v[16 * c + 3] * 64.f); o.y = cvt4_fp8(v[16 * c + 4] * 64.f, v[16 * c + 5] * 64.f, v[16 * c + 6] * 64.f, v[16 * c + 7] * 64.f);
                o.z = cvt4_fp8(v[16 * c + 8] * 64.f, v[16 * c + 9] * 64.f, v[16 * c + 10] * 64.f, v[16 * c + 11] * 64.f); o.w = cvt4_fp8(v[16 * c + 12] * 64.f, v[16 * c + 13] * 64.f, v[16 * c + 14] * 64.f, v[16 * c + 15] * 64.f);
                *(u32x4*)(base + dr * 2048 + k0 + 16 * jq) = o; }
            asm volatile("s_waitcnt lgkmcnt(0)" ::: "memory");
            __builtin_amdgcn_s_barrier();
        }
        asm volatile("s_waitcnt vmcnt(0)" ::: "memory");
        __syncthreads();
#undef P0_DECODE
#undef P0_ISSUE
    }
    LAS float* s_c = (LAS float*)lds;
    LAS float* s_red = s_c + 2048 * 8;
    float* mod = (float*)(a.ws + WS_MOD);
    for (int it = bid; it < 256; it += G) {
        __syncthreads();
        for (int i = tid; i < 8 * 2048; i += 512) { const int b = i >> 11, k = i & 2047; const float v = a.in[I_C][i]; s_c[k * 8 + b] = v * sigmoidf_(v); }
        __syncthreads();
        const int c4 = lane % 12, kq = lane / 12;
        f32x4 acc[8];
#pragma unroll
        for (int b = 0; b < 8; ++b) acc[b] = (f32x4){0.f, 0.f, 0.f, 0.f};
        if (kq < 5) {
            const float* wp = a.in[I_WADA] + (size_t)(wave * 256) * 12288 + it * 48 + 4 * c4;
            for (int i0 = 0; i0 < 52; i0 += 13) {
                f32x4 w4[13];
#pragma unroll
                for (int u = 0; u < 13; ++u) { const int k = kq + 5 * (i0 + u), kc = k < 256 ? k : 255; w4[u] = *(const f32x4*)(wp + (size_t)kc * 12288); }
                asm volatile("" ::: "memory");
#pragma unroll
                for (int u = 0; u < 13; ++u) { const int k = kq + 5 * (i0 + u), kc = k < 256 ? k : 255; const float m = k < 256 ? 1.0f : 0.0f;
                    const f32x4 s0 = *(const LAS f32x4*)(s_c + (wave * 256 + kc) * 8) * m, s1 = *(const LAS f32x4*)(s_c + (wave * 256 + kc) * 8 + 4) * m;
                    acc[0] += w4[u] * s0[0]; acc[1] += w4[u] * s0[1]; acc[2] += w4[u] * s0[2]; acc[3] += w4[u] * s0[3];
                    acc[4] += w4[u] * s1[0]; acc[5] += w4[u] * s1[1]; acc[6] += w4[u] * s1[2]; acc[7] += w4[u] * s1[3]; }
            }
#pragma unroll
            for (int b = 0; b < 8; ++b) *(LAS f32x4*)(s_red + ((wave * 5 + kq) * 8 + b) * 48 + 4 * c4) = acc[b];
        }
        __syncthreads();
        if (tid < 384) { const int b = tid / 48, cc = tid % 48; float s = 0.f;
#pragma unroll 8
            for (int w = 0; w < 40; ++w) s += s_red[(w * 8 + b) * 48 + cc];
            mod[b * 12288 + it * 48 + cc] = s + a.in[I_BADA][it * 48 + cc]; }
    }
    if (bid < 16) {
        const int it = bid * 512 + tid, ln = it & 63, f = it >> 6, h = f & 1, ks = (f >> 1) & 3, c = (f >> 3) & 1, wv_ = f >> 4;
        float wv[8];
#pragma unroll
        for (int j = 0; j < 8; ++j) wv[j] = a.in[I_RW][(size_t)(1024 * c + 128 * wv_ + 32 * ks + 8 * (ln >> 4) + j) * 32 + 16 * h + (ln & 15)];
        u32x4 hi_, lo_;
#pragma unroll
        for (int q = 0; q < 4; ++q) { const unsigned hp = cvt_pk_bf16(wv[2 * q], wv[2 * q + 1]); hi_[q] = hp; lo_[q] = cvt_pk_bf16(wv[2 * q] - bf_lo(hp), wv[2 * q + 1] - bf_hi(hp)); }
        u32x4* tb = (u32x4*)(a.ws + WS_WRT) + ((size_t)f * 2) * 64 + ln; tb[0] = hi_; tb[64] = lo_;
    } else if (bid < 24) {
        const int it = (bid - 16) * 512 + tid, ln = it & 63, f = it >> 6, ks = f & 3, c = (f >> 2) & 1, wv_ = f >> 3;
        float wv[8];
#pragma unroll
        for (int j = 0; j < 8; ++j) wv[j] = (ln & 8) ? 0.f : a.in[I_WIN][(size_t)(1024 * c + 128 * wv_ + 32 * ks + 8 * (ln >> 4) + j) * DIN + DINP + (ln & 7)];
        u32x4 hi_, lo_;
#pragma unroll
        for (int q = 0; q < 4; ++q) { const unsigned hp = cvt_pk_bf16(wv[2 * q], wv[2 * q + 1]); hi_[q] = hp; lo_[q] = cvt_pk_bf16(wv[2 * q] - bf_lo(hp), wv[2 * q + 1] - bf_hi(hp)); }
        u32x4* tb = (u32x4*)(a.ws + WS_WRT + 524288) + ((size_t)f * 2) * 64 + ln; tb[0] = hi_; tb[64] = lo_;
    }
}

constexpr int PT_STR = 1032, PT_LO = 16 * PT_STR * 2;
__device__ __forceinline__ void pt_put(LAS unsigned char* tile, int row, int ch, f32x4 v) {
    const unsigned h0 = cvt_pk_bf16(v[0], v[1]), h1 = cvt_pk_bf16(v[2], v[3]);
    const unsigned l0 = cvt_pk_bf16(v[0] - bf_lo(h0), v[1] - bf_hi(h0)), l1 = cvt_pk_bf16(v[2] - bf_lo(h1), v[3] - bf_hi(h1));
    *(LAS u32x2*)(tile + row * (PT_STR * 2) + ch * 2) = (u32x2){h0, h1}; *(LAS u32x2*)(tile + PT_LO + row * (PT_STR * 2) + ch * 2) = (u32x2){l0, l1};
}
#define MFMA16(a, b, c) __builtin_amdgcn_mfma_f32_16x16x32_bf16((a), (b), (c), 0, 0, 0)
__device__ __forceinline__ void phase1(const Args& a, LAS unsigned char* lds, int bid, int G, int tid) {
    const int lane = tid & 63, wave = tid >> 6;
    LAS float* s_sc = (LAS float*)lds; LAS float* s_sh = s_sc + 2048; LAS unsigned char* tile = lds + 16384; LAS float* red = (LAS float*)(lds + 16384 + 2 * PT_LO);
    const float* mod = (const float*)(a.ws + WS_MOD); float* gates = (float*)(a.ws + WS_GATES); unsigned char* h8 = a.ws + WS_HF8;
    const float* x = a.in[I_X];
    float ghi[2][4][4], glo[2][4][4];
    { const u32x4* tb = (const u32x4*)(a.ws + WS_WRT + 524288) + (size_t)(wave * 8) * 2 * 64 + lane;
#pragma unroll
      for (int c = 0; c < 2; ++c)
#pragma unroll
          for (int ks = 0; ks < 4; ++ks) { const int f = c * 4 + ks; const u32x4 hv_ = tb[(f * 2) * 64], lv_ = tb[(f * 2 + 1) * 64];
#pragma unroll
              for (int q = 0; q < 4; ++q) { asm volatile("v_accvgpr_write_b32 %0, %1" : "=a"(ghi[c][ks][q]) : "v"(hv_[q])); asm volatile("v_accvgpr_write_b32 %0, %1" : "=a"(glo[c][ks][q]) : "v"(lv_[q])); } } }
    for (int p = bid; p < T / 128; p += G) {
        const int b = (p * 128) / SEQ;
        __syncthreads();
        { int l_; asm volatile("v_mbcnt_lo_u32_b32 %0, -1, 0\n\tv_mbcnt_hi_u32_b32 %0, -1, %0" : "=v"(l_)); const int t0 = __builtin_amdgcn_readfirstlane(wave) * 64 + l_;
          for (int i = t0; i < 2048; i += 512) { s_sh[i] = mod[b * 12288 + i]; s_sc[i] = 1.0f + mod[b * 12288 + 2048 + i]; } }
        __syncthreads();
        f32x4 nx[8];
        { const f32x4* xr = (const f32x4*)(x + (size_t)(p * 128 + 2 * wave) * D) + lane;
#pragma unroll
          for (int j = 0; j < 8; ++j) nx[j] = xr[64 * j]; }
        for (int tl = 0; tl < 8; ++tl) {
            f32x4 hc1[2][4];
#pragma unroll
            for (int rr = 0; rr < 2; ++rr) {
                const int row = p * 128 + tl * 16 + 2 * wave + rr;
                f32x4 v[8]; float s = 0.f;
#pragma unroll
                for (int j = 0; j < 8; ++j) { v[j] = nx[j]; s += (v[j][0] + v[j][1]) + (v[j][2] + v[j][3]); }
                { const int rn = rr == 0 ? row + 1 : (tl < 7 ? row + 15 : row); const f32x4* xr = (const f32x4*)(x + (size_t)rn * D) + lane;
#pragma unroll
                  for (int j = 0; j < 8; ++j) nx[j] = xr[64 * j]; }
                const float mean = wave_sum(s) * (1.0f / D); float s2 = 0.f;
#pragma unroll
                for (int j = 0; j < 8; ++j) { v[j] = v[j] - mean; s2 += (v[j][0] * v[j][0] + v[j][1] * v[j][1]) + (v[j][2] * v[j][2] + v[j][3] * v[j][3]); }
                const float rstd = 1.0f / sqrtf(wave_sum(s2) * (1.0f / D) + LN_EPS);
                unsigned* o4 = (unsigned*)(h8 + (size_t)row * D) + lane;
#pragma unroll
                for (int j = 0; j < 8; ++j) { const f32x4 sc = *(const LAS f32x4*)(s_sc + 4 * lane + 256 * j), sh = *(const LAS f32x4*)(s_sh + 4 * lane + 256 * j);
                    const f32x4 hv = v[j] * rstd * sc + sh; o4[64 * j] = cvt4_fp8(hv[0], hv[1], hv[2], hv[3]);
                    if (j < 4) pt_put(tile, 2 * wave + rr, 4 * lane + 256 * j, hv); else hc1[rr][j - 4] = hv; }
                asm volatile("" ::: "memory");
            }
            f32x4 acc = (f32x4){0.f, 0.f, 0.f, 0.f};
#pragma unroll
            for (int c = 0; c < 2; ++c) {
                if (c == 1) {
                    __syncthreads();
#pragma unroll
                    for (int rr = 0; rr < 2; ++rr)
#pragma unroll
                        for (int jj = 0; jj < 4; ++jj) pt_put(tile, 2 * wave + rr, 4 * lane + 256 * jj, hc1[rr][jj]);
                }
                __syncthreads();
                const LAS unsigned char* ap = tile + (lane & 15) * (PT_STR * 2) + (128 * wave + 8 * (lane >> 4)) * 2;
#pragma unroll
                for (int ks = 0; ks < 4; ++ks) { const bf16x8 ah = *(const LAS bf16x8*)(ap + 64 * ks), al = *(const LAS bf16x8*)(ap + PT_LO + 64 * ks);
#pragma unroll
                    for (int q = 0; q < 4; ++q) asm volatile("" : "+a"(ghi[c][ks][q]), "+a"(glo[c][ks][q]));
                    const bf16x8 bh = __builtin_bit_cast(bf16x8, (f32x4){ghi[c][ks][0], ghi[c][ks][1], ghi[c][ks][2], ghi[c][ks][3]});
                    const bf16x8 bl = __builtin_bit_cast(bf16x8, (f32x4){glo[c][ks][0], glo[c][ks][1], glo[c][ks][2], glo[c][ks][3]});
                    acc = MFMA16(ah, bh, acc); acc = MFMA16(ah, bl, acc); acc = MFMA16(al, bh, acc); }
            }
#pragma unroll
            for (int q = 0; q < 4; ++q) red[(wave * 16 + 4 * (lane >> 4) + q) * 16 + (lane & 15)] = acc[q];
            __syncthreads();
            if (tid < 128) { const int rw_ = tid >> 3, gq = tid & 7; float g = a.in[I_BIN][DINP + gq];
#pragma unroll
                for (int w = 0; w < 8; ++w) g += red[(w * 16 + rw_) * 16 + gq];
                gates[(size_t)(p * 128 + tl * 16 + rw_) * 8 + gq] = g; }
        }
    }
}

constexpr int ML_QK = 32768, ML_K = 16384;
constexpr int ML_VR = 3 * ML_QK, ML_SCS = ML_VR + 3 * 4096;
constexpr int ML_CT = ML_SCS + 3 * 2048;
__device__ __forceinline__ unsigned off_b(unsigned row, unsigned ch) { return 256u * row + 16u * (ch ^ (((row & 3u) << 2) | ((row >> 2) & 3u))); }
__device__ __forceinline__ s16x4 vtr(const LAS unsigned char* p) { return __builtin_bit_cast(s16x4, __builtin_amdgcn_ds_read_tr16_b64_v4i16((LAS v4i16_t*)p)); }
__device__ __forceinline__ bf16x8 cat8(s16x4 lo, s16x4 hi) { return __builtin_shufflevector(lo, hi, 0, 1, 2, 3, 4, 5, 6, 7); }
__device__ __forceinline__ float scan_add(float v, int lane) {
#pragma unroll
    for (int d = 1; d < 64; d <<= 1) { const float t = __shfl_up(v, d); v = (lane >= d) ? v + t : v; }
    return v;
}
__device__ __forceinline__ float scan_max(float v, int lane) {
#pragma unroll
    for (int d = 1; d < 64; d <<= 1) { const float t = __shfl_up(v, d); v = (lane >= d) ? fmaxf(v, t) : v; }
    return v;
}

__device__ __forceinline__ void mlstm_chain(const Args& a, LAS unsigned char* lds, int chain, int slice, int tid) {
    const int lane = tid & 63, wave = __builtin_amdgcn_readfirstlane(tid >> 6);
    const int b = chain >> 2, hd = chain & 3;
    const bf16_t* z = (const bf16_t*)(a.ws + WS_Z); const float* gates = (const float*)(a.ws + WS_GATES); bf16_t* hbuf = (bf16_t*)(a.ws + WS_HBUF);
    const size_t tb = (size_t)b * SEQ;
    const int qcol = 1024 + hd * 128, kcol = 1536 + hd * 128, vcol = 2048 + hd * 256 + slice * 32;
    const int l_loc = lane & 15, g = lane >> 4, q4 = l_loc >> 2, p4 = l_loc & 3;
    const unsigned ldsbase = (unsigned)(__UINTPTR_TYPE__)lds;
    float* scal = (float*)(a.ws + WS_SCAL) + (size_t)(chain * 8 + slice) * (64 * 384);
    f32x4 st[2][3];
#pragma unroll
    for (int i = 0; i < 2; ++i)
#pragma unroll
        for (int c = 0; c < 3; ++c) st[i][c] = (f32x4){0.f, 0.f, 0.f, 0.f};

    {
        LAS float* pA = (LAS float*)(lds + 65536); LAS float* pB = pA + 4096; LAS float* pM = pB + 4096; LAS float* pC = pM + 4096;
        float giA[8], gfA[8];
#pragma unroll
        for (int j = 0; j < 8; ++j) { const size_t t0_ = tb + (size_t)(wave + 8 * j) * 64; giA[j] = gates[(t0_ + lane) * 8 + hd]; gfA[j] = gates[(t0_ + lane) * 8 + 4 + hd]; }
        asm volatile("" ::: "memory");
#pragma unroll
        for (int j = 0; j < 8; ++j) { const int c = wave + 8 * j;
            const float gi_ = giA[j], gf_ = gfA[j];
            const float lf_ = fminf(gf_, 0.f) - log1pf(__expf(-fabsf(gf_)));
            const float bb_ = scan_add(lf_, lane), aa_ = gi_ - bb_, am_ = scan_max(aa_, lane);
            pA[c * 64 + lane] = aa_; pB[c * 64 + lane] = bb_; pM[c * 64 + lane] = am_;
            if (lane == 63) { pC[c] = bb_; pC[64 + c] = am_; }
        }
        __syncthreads();
        if (wave == 0) {
            float p_ = pC[lane], q_ = pC[64 + lane] + p_;
#pragma unroll
            for (int d = 1; d < 64; d <<= 1) { const float pp = __shfl_up(p_, d), qp = __shfl_up(q_, d); if (lane >= d) { q_ = fmaxf(qp + p_, q_); p_ = pp + p_; } }
            const float m_after = fmaxf(p_, q_);
            float m_in_ = __shfl_up(m_after, 1); if (lane == 0) m_in_ = 0.f;
            pC[128 + lane] = m_in_; pC[192 + lane] = fmaxf(m_in_, pC[64 + lane]);
        }
        __syncthreads();
        for (int c = wave; c < 64; c += 8) {
            const float aa_ = pA[c * 64 + lane], bb_ = pB[c * 64 + lane], am_ = pM[c * 64 + lane], m_in_ = pC[128 + c], mxa_ = pC[192 + c];
            const float mx_ = fmaxf(m_in_, am_);
            float* o_ = scal + (size_t)c * 384;
            o_[lane] = aa_; o_[64 + lane] = -mx_; o_[128 + lane] = __expf(m_in_ - mx_); o_[192 + lane] = __expf(-(bb_ + mx_)); o_[256 + lane] = __expf(aa_ - mxa_);
            if (lane == 0) o_[320] = __expf(m_in_ - mxa_);
        }
        asm volatile("s_waitcnt vmcnt(0)" ::: "memory");
        __syncthreads();
    }
#define ML_DMA(ldsaddr_, gptr_) asm volatile("s_mov_b32 m0, %0\n\ts_nop 0\n\tglobal_load_lds_dwordx4 %1, off" :: "s"(ldsaddr_), "v"(gptr_) : "memory")
#define ML_ISSUE(c_, cb_) do { const size_t t0_ = tb + (size_t)(c_) * 64; const unsigned cbu_ = (unsigned)__builtin_amdgcn_readfirstlane(cb_); const unsigned qb_ = ldsbase + cbu_ * (unsigned)ML_QK; \
        _Pragma("unroll") for (int i_ = 0; i_ < 2; ++i_) { const int r_ = 4 * (i_ * 8 + wave) + (lane >> 4), ch_ = (lane & 15) ^ (((r_ & 3) << 2) | ((r_ >> 2) & 3)); \
            const bf16_t* gq_ = z + (t0_ + r_) * ZW + qcol + 8 * ch_; const bf16_t* gk_ = z + (t0_ + r_) * ZW + kcol + 8 * ch_; \
            ML_DMA(qb_ + (unsigned)(i_ * 8 + wave) * 1024u, gq_); ML_DMA(qb_ + (unsigned)ML_K + (unsigned)(i_ * 8 + wave) * 1024u, gk_); } \
        if (wave < 4) { const bf16_t* gv_ = z + (t0_ + (tid >> 2)) * ZW + vcol + 8 * (tid & 3); ML_DMA(ldsbase + (unsigned)ML_VR + cbu_ * 4096u + (unsigned)wave * 1024u, gv_); } \
        else if (wave == 4) { const float* gs_ = scal + (size_t)(c_) * 384 + 4 * lane; ML_DMA(ldsbase + (unsigned)ML_SCS + cbu_ * 2048u, gs_); } \
        else if (wave == 5) { if (lane < 32) { const float* gs_ = scal + (size_t)(c_) * 384 + 256 + 4 * lane; ML_DMA(ldsbase + (unsigned)ML_SCS + cbu_ * 2048u + 1024u, gs_); } } } while (0)

    for (int i = tid; i < 12288 / 16; i += 512) *(LAS u32x4*)(lds + ML_CT + 16 * i) = (u32x4){0u, 0u, 0u, 0u};
    ML_ISSUE(0, 0); ML_ISSUE(1, 1);
    if (wave < 6) asm volatile("s_waitcnt vmcnt(5)" ::: "memory"); else asm volatile("s_waitcnt vmcnt(4)" ::: "memory");
    __syncthreads();
    int cb = 0;
    for (int c = 0; c < 64; ++c) {
        const int bsel = c & 1;
        const LAS unsigned char* BQ = lds + cb * ML_QK;
        const LAS unsigned char* BV = lds + ML_VR + cb * 4096;
        const LAS float* sc = (const LAS float*)(lds + ML_SCS + cb * 2048);
        const LAS unsigned char* ctc = lds + ML_CT + bsel * 12288;
        LAS unsigned char* ctn = lds + ML_CT + (bsel ^ 1) * 12288;
        { const int cb2 = cb == 0 ? 2 : cb - 1; if (c + 2 < 64) ML_ISSUE(c + 2, cb2); }
        if (wave < 4) {
            const int mt = wave, l = 16 * mt + l_loc;
            bf16x8 qf[4];
#pragma unroll
            for (int ks = 0; ks < 4; ++ks) qf[ks] = *(const LAS bf16x8*)(BQ + off_b(l, 4 * ks + g));
            f32x4 aS[4];
#pragma unroll
            for (int np = 0; np < 2; ++np) { bf16x8 kf[2][4];
#pragma unroll
                for (int h = 0; h < 2; ++h)
#pragma unroll
                    for (int ks = 0; ks < 4; ++ks) kf[h][ks] = *(const LAS bf16x8*)(BQ + ML_K + off_b(16 * (2 * np + h) + l_loc, 4 * ks + g));
                asm volatile("" ::: "memory");
                aS[2 * np] = (f32x4){0.f, 0.f, 0.f, 0.f}; aS[2 * np + 1] = (f32x4){0.f, 0.f, 0.f, 0.f};
#pragma unroll
                for (int ks = 0; ks < 4; ++ks) { aS[2 * np] = MFMA16(kf[0][ks], qf[ks], aS[2 * np]); aS[2 * np + 1] = MFMA16(kf[1][ks], qf[ks], aS[2 * np + 1]); }
                asm volatile("" ::: "memory"); }
            f32x4 aC[3];
            { bf16x8 cf[2][4];
#pragma unroll
              for (int h = 0; h < 2; ++h)
#pragma unroll
                  for (int ks = 0; ks < 4; ++ks) cf[h][ks] = *(const LAS bf16x8*)(ctc + off_b(16 * h + l_loc, 4 * ks + g));
              asm volatile("" ::: "memory");
              aC[0] = (f32x4){0.f, 0.f, 0.f, 0.f}; aC[1] = (f32x4){0.f, 0.f, 0.f, 0.f};
#pragma unroll
              for (int ks = 0; ks < 4; ++ks) { aC[0] = MFMA16(cf[0][ks], qf[ks], aC[0]); aC[1] = MFMA16(cf[1][ks], qf[ks], aC[1]); }
              asm volatile("" ::: "memory");
#pragma unroll
              for (int ks = 0; ks < 4; ++ks) cf[0][ks] = *(const LAS bf16x8*)(ctc + off_b(32 + l_loc, 4 * ks + g));
              asm volatile("" ::: "memory");
              aC[2] = (f32x4){0.f, 0.f, 0.f, 0.f};
#pragma unroll
              for (int ks = 0; ks < 4; ++ks) aC[2] = MFMA16(cf[0][ks], qf[ks], aC[2]); }
            const float rowv_l = sc[64 + l], winter_l = sc[128 + l], emq_l = sc[192 + l];
            float rowsum = 0.f; unsigned pk[4][2];
#pragma unroll
            for (int nt = 0; nt < 4; ++nt) { const f32x4 a4 = *(const LAS f32x4*)(sc + 16 * nt + 4 * g); float p[4];
#pragma unroll
                for (int r = 0; r < 4; ++r) { const int s = 16 * nt + 4 * g + r; p[r] = (s <= l) ? aS[nt][r] * __expf(rowv_l + a4[r]) : 0.f; rowsum += p[r]; }
                pk[nt][0] = cvt_pk_bf16(p[0], p[1]); pk[nt][1] = cvt_pk_bf16(p[2], p[3]); }
            f32x4 aO[2];
#pragma unroll
            for (int cc = 0; cc < 2; ++cc) { aO[cc] = (f32x4){0.f, 0.f, 0.f, 0.f};
#pragma unroll
                for (int ks = 0; ks < 2; ++ks) {
                    const s16x4 lo = vtr(BV + (32 * ks + 4 * g + q4) * 64 + (16 * cc + 4 * p4) * 2), hi = vtr(BV + (32 * ks + 16 + 4 * g + q4) * 64 + (16 * cc + 4 * p4) * 2);
                    const u32x4 pw = (u32x4){pk[2 * ks][0], pk[2 * ks][1], pk[2 * ks + 1][0], pk[2 * ks + 1][1]};
                    aO[cc] = MFMA16(cat8(lo, hi), __builtin_bit_cast(bf16x8, pw), aO[cc]); } }
            const float qn = __shfl(aC[2][0], l_loc);
            float rs = rowsum; rs += __shfl_xor(rs, 16); rs += __shfl_xor(rs, 32);
            const float den = rs + winter_l * qn;
            const float inv = __builtin_amdgcn_rcpf(fmaxf(fabsf(den), emq_l));
            bf16_t* orow = hbuf + (tb + (size_t)c * 64 + l) * 1024 + hd * 256 + slice * 32 + 4 * g;
#pragma unroll
            for (int cc = 0; cc < 2; ++cc) { const f32x4 o = (aO[cc] + aC[cc] * winter_l) * inv; u32x2 w; w.x = cvt_pk_bf16(o[0], o[1]); w.y = cvt_pk_bf16(o[2], o[3]); *(u32x2*)(orow + 16 * cc) = w; }
        } else {
            const int w2 = wave - 4; const float decay_cur = sc[320];
#pragma unroll
            for (int i = 0; i < 2; ++i)
#pragma unroll
                for (int cc = 0; cc < 3; ++cc) st[i][cc] = st[i][cc] * decay_cur;
#pragma unroll
            for (int ks = 0; ks < 2; ++ks) {
                const f32x4 wl = *(const LAS f32x4*)(sc + 256 + 32 * ks + 8 * g), wh = *(const LAS f32x4*)(sc + 256 + 32 * ks + 8 * g + 4);
                bf16x8 vw[3];
#pragma unroll
                for (int cc = 0; cc < 2; ++cc) { const u32x2 lo = __builtin_bit_cast(u32x2, vtr(BV + (32 * ks + 8 * g + q4) * 64 + (16 * cc + 4 * p4) * 2)), hi = __builtin_bit_cast(u32x2, vtr(BV + (32 * ks + 8 * g + 4 + q4) * 64 + (16 * cc + 4 * p4) * 2));
                    const u32x4 sv_ = (u32x4){cvt_pk_bf16(bf_lo(lo.x) * wl[0], bf_hi(lo.x) * wl[1]), cvt_pk_bf16(bf_lo(lo.y) * wl[2], bf_hi(lo.y) * wl[3]), cvt_pk_bf16(bf_lo(hi.x) * wh[0], bf_hi(hi.x) * wh[1]), cvt_pk_bf16(bf_lo(hi.y) * wh[2], bf_hi(hi.y) * wh[3])};
                    vw[cc] = __builtin_bit_cast(bf16x8, sv_); }
                { const u32x4 on_ = (u32x4){cvt_pk_bf16(wl[0], wl[1]), cvt_pk_bf16(wl[2], wl[3]), cvt_pk_bf16(wh[0], wh[1]), cvt_pk_bf16(wh[2], wh[3])};
                  vw[2] = __builtin_bit_cast(bf16x8, l_loc == 0 ? on_ : (u32x4){0u, 0u, 0u, 0u}); }
#pragma unroll
                for (int i = 0; i < 2; ++i) { const int mt2 = 2 * w2 + i;
                    const bf16x8 kt = cat8(vtr(BQ + ML_K + off_b(32 * ks + 8 * g + q4, 2 * mt2 + (p4 >> 1)) + 8 * (p4 & 1)), vtr(BQ + ML_K + off_b(32 * ks + 8 * g + 4 + q4, 2 * mt2 + (p4 >> 1)) + 8 * (p4 & 1)));
#pragma unroll
                    for (int cc = 0; cc < 3; ++cc) st[i][cc] = MFMA16(kt, vw[cc], st[i][cc]); }
            }
#pragma unroll
            for (int i = 0; i < 2; ++i) { const int mt2 = 2 * w2 + i;
#pragma unroll
                for (int cc = 0; cc < 3; ++cc) { u32x2 w; w.x = cvt_pk_bf16(st[i][cc][0], st[i][cc][1]); w.y = cvt_pk_bf16(st[i][cc][2], st[i][cc][3]);
                    *(LAS u32x2*)(ctn + off_b(16 * cc + l_loc, 2 * mt2 + (g >> 1)) + 8 * (g & 1)) = w; } }
        }
        if (c + 2 < 64) { if (wave < 4) asm volatile("s_waitcnt vmcnt(7)" ::: "memory"); else if (wave < 6) asm volatile("s_waitcnt vmcnt(5)" ::: "memory"); else asm volatile("s_waitcnt vmcnt(4)" ::: "memory"); }
        else { if (wave < 4) asm volatile("s_waitcnt vmcnt(2)" ::: "memory"); else asm volatile("s_waitcnt vmcnt(0)" ::: "memory"); }
        __syncthreads();
        cb = cb == 2 ? 0 : cb + 1;
    }
#undef ML_DMA
#undef ML_ISSUE
}

template <int I0, int CNT>
__device__ __forceinline__ void conv_load(const bf16_t* z, int t0, int p0, int c0, unsigned (&ru)[16]) {
#pragma unroll
    for (int q = 0; q < CNT; ++q) { const int i = I0 + q; const bool ok = (p0 - 30 + i >= 0);
        ru[q] = *(const unsigned*)(z + (size_t)(ok ? t0 - 30 + i : t0) * ZW + c0); }
}
__device__ __forceinline__ float dot2bf(unsigned w, unsigned u, float c) { return __builtin_amdgcn_fdot2_f32_bf16(__builtin_bit_cast(bf16x2_t, w), __builtin_bit_cast(bf16x2_t, u), c, false); }
template <int I0, int CNT>
__device__ __forceinline__ void conv_use(int p0, const unsigned (&ru)[16], unsigned& prev, const unsigned (&w0)[16], const unsigned (&w1)[16], float (&y0)[16], float (&y1)[16]) {
    unsigned r[CNT + 1];
#pragma unroll
    for (int q = 0; q < CNT; ++q) r[q] = (p0 - 30 + I0 + q >= 0) ? ru[q] : 0u;
    r[CNT] = 0u;
#pragma unroll
    for (int m = 0; m < (CNT + 1) / 2; ++m) {
        const int s = I0 + 2 * m;
        const unsigned e0 = __builtin_amdgcn_perm(r[2 * m + 1], r[2 * m], 0x05040100u), e1 = __builtin_amdgcn_perm(r[2 * m + 1], r[2 * m], 0x07060302u);
#pragma unroll
        for (int jj = 0; jj < 16; ++jj) { const int t = s - 2 * jj; if (t >= 0 && t <= 15) { y0[t] = dot2bf(w0[jj], e0, y0[t]); y1[t] = dot2bf(w1[jj], e1, y1[t]); } }
    }
#pragma unroll
    for (int m = 0; m < CNT / 2 + (I0 + CNT == 46 ? 1 : 0); ++m) {
        const int s = I0 - 1 + 2 * m;
        if (s < 1 || s > 45) continue;
        const unsigned lo = (m == 0) ? prev : r[2 * m - 1], hi = r[2 * m];
        const unsigned o0 = __builtin_amdgcn_perm(hi, lo, 0x05040100u), o1 = __builtin_amdgcn_perm(hi, lo, 0x07060302u);
#pragma unroll
        for (int jj = 0; jj < 16; ++jj) { const int t = s - 2 * jj; if (t >= 0 && t <= 15) { y0[t] = dot2bf(w0[jj], o0, y0[t]); y1[t] = dot2bf(w1[jj], o1, y1[t]); } }
    }
    prev = r[CNT - 1];
}
__device__ __forceinline__ void conv_phase(const Args& a, LAS unsigned char* lds, int bid, int G, int tid) {
    const int lane = tid & 63, wave = tid >> 6, c0 = 2 * tid;
    const bf16_t* z = (const bf16_t*)(a.ws + WS_Z); unsigned char* ymix = a.ws + WS_YMIX;
    LAS float* red = (LAS float*)lds;
    unsigned w0[16], w1[16];
#pragma unroll
    for (int jj = 0; jj < 16; ++jj) { const f32x2 wa = *(const f32x2*)(a.in[I_DWW] + (2 * jj) * 1024 + c0); f32x2 wb = (f32x2){0.f, 0.f}; if (jj < 15) wb = *(const f32x2*)(a.in[I_DWW] + (2 * jj + 1) * 1024 + c0);
        w0[jj] = cvt_pk_bf16(wa[0], wb[0]); w1[jj] = cvt_pk_bf16(wa[1], wb[1]); }
    const f32x2 bias = *(const f32x2*)(a.in[I_DWB] + c0);
    const f32x2 lg = *(const f32x2*)(a.in[I_CLG] + c0), lb = *(const f32x2*)(a.in[I_CLB] + c0);
    LAS unsigned char* ring = lds + 4096;
    const unsigned ringbase = (unsigned)(__UINTPTR_TYPE__)ring;
    const int wave_u = __builtin_amdgcn_readfirstlane(wave);
    const int nU = T / 16, u_beg = (int)((long)bid * nU / G), u_end = (int)((long)(bid + 1) * nU / G), tbeg = u_beg * 16;
#define CV_DMA(ldsaddr_, gptr_) asm volatile("s_mov_b32 m0, %0\n\ts_nop 0\n\tglobal_load_lds_dwordx4 %1, off" :: "s"(ldsaddr_), "v"(gptr_) : "memory")
#define CV_ISSUE(trow_) do { _Pragma("unroll") for (int q_ = 0; q_ < 4; ++q_) { const int pc_ = wave_u * 4 + q_, t_ = (trow_) + (pc_ >> 1), hf_ = pc_ & 1; \
        const int sq0_ = ((trow_) + 16 > 0 ? ((trow_) + 15) & ~(SEQ - 1) : 0), tc_ = t_ < sq0_ ? sq0_ : t_; \
        const bf16_t* gp_ = z + (size_t)tc_ * ZW + hf_ * 512 + 8 * lane; \
        CV_DMA(ringbase + (unsigned)(((t_ - tbeg + 32) & 63) * 2048 + hf_ * 1024), gp_); } } while (0)
    if (u_beg < u_end) { CV_ISSUE(tbeg - 32); CV_ISSUE(tbeg - 16); CV_ISSUE(tbeg); }
    asm volatile("s_waitcnt vmcnt(0)" ::: "memory");
    __syncthreads();
    unsigned ra0[16];
    for (int unit = u_beg, it_ = 0; unit < u_end; ++unit, ++it_) {
        const int t0 = unit * 16, p0 = t0 & (SEQ - 1);
        if (unit + 1 < u_end) CV_ISSUE(t0 + 16);
        float y0[16], y1[16]; unsigned prev = 0u;
#pragma unroll
        for (int t = 0; t < 16; ++t) { y0[t] = bias[0]; y1[t] = bias[1]; }
#define CV_RING(I0_, CNT_) do { _Pragma("unroll") for (int q_ = 0; q_ < (CNT_); ++q_) ra0[q_] = *(const LAS unsigned*)(ring + ((t0 - 30 + (I0_) + q_ - tbeg + 32) & 63) * 2048 + c0 * 2); } while (0)
        CV_RING(0, 16);  conv_use<0, 16>(p0, ra0, prev, w0, w1, y0, y1);
        CV_RING(16, 16); conv_use<16, 16>(p0, ra0, prev, w0, w1, y0, y1);
        CV_RING(32, 14); conv_use<32, 14>(p0, ra0, prev, w0, w1, y0, y1);
#undef CV_RING
        asm volatile("s_waitcnt vmcnt(0)" ::: "memory");
        { LAS float* rb = red + (it_ & 1) * (8 * 32);
#pragma unroll
          for (int t = 0; t < 16; ++t) { const float s1 = wave_sum(y0[t] + y1[t]), s2 = wave_sum(y0[t] * y0[t] + y1[t] * y1[t]); if (lane == 0) { rb[(wave * 16 + t) * 2] = s1; rb[(wave * 16 + t) * 2 + 1] = s2; } }
          __syncthreads();
          float s1 = 0.f, s2 = 0.f;
#pragma unroll
          for (int ww = 0; ww < 8; ++ww) { const f32x2 pr = *(const LAS f32x2*)(rb + (ww * 16 + (lane & 15)) * 2); s1 += pr[0]; s2 += pr[1]; }
          const float meanv = s1 * (1.0f / 1024.0f), varv = fmaxf(s2 * (1.0f / 1024.0f) - meanv * meanv, 0.f), rstdv = 1.0f / sqrtf(varv + LN_EPS);
#pragma unroll
          for (int t = 0; t < 16; ++t) { const float mean = __uint_as_float(__builtin_amdgcn_readlane(__float_as_uint(meanv), t)), rstd = __uint_as_float(__builtin_amdgcn_readlane(__float_as_uint(rstdv), t));
              const float v0 = (y0[t] - mean) * rstd * lg[0] + lb[0], v1 = (y1[t] - mean) * rstd * lg[1] + lb[1];
              *(unsigned short*)(ymix + (size_t)(t0 + t) * D + c0) = (unsigned short)__builtin_amdgcn_cvt_pk_fp8_f32(v0 * sigmoidf_(v0), v1 * sigmoidf_(v1), 0, false); } }
    }
#undef CV_DMA
#undef CV_ISSUE
}

__device__ __forceinline__ void phase_postnorm(const Args& a, int bid, int G, int tid) {
    const int lane = tid & 63, wave = tid >> 6;
    const bf16_t* z = (const bf16_t*)(a.ws + WS_Z); const bf16_t* hbuf = (const bf16_t*)(a.ws + WS_HBUF); unsigned char* ymix = a.ws + WS_YMIX;
    f32x4 gg[4];
#pragma unroll
    for (int j = 0; j < 4; ++j) gg[j] = *(const f32x4*)(a.in[I_MHG] + 16 * lane + 4 * j);
    for (int row = bid * 8 + wave; row < T; row += G * 8) {
        const u32x4* hp = (const u32x4*)(hbuf + (size_t)row * 1024 + 16 * lane); const u32x4* op = (const u32x4*)(z + (size_t)row * ZW + 3072 + 16 * lane);
        const u32x4 h0 = hp[0], h1 = hp[1], o0 = op[0], o1 = op[1];
        float hv[16], ov[16];
        hv[0] = bf_lo(h0.x); hv[1] = bf_hi(h0.x); hv[2] = bf_lo(h0.y); hv[3] = bf_hi(h0.y); hv[4] = bf_lo(h0.z); hv[5] = bf_hi(h0.z); hv[6] = bf_lo(h0.w); hv[7] = bf_hi(h0.w);
        hv[8] = bf_lo(h1.x); hv[9] = bf_hi(h1.x); hv[10] = bf_lo(h1.y); hv[11] = bf_hi(h1.y); hv[12] = bf_lo(h1.z); hv[13] = bf_hi(h1.z); hv[14] = bf_lo(h1.w); hv[15] = bf_hi(h1.w);
        ov[0] = bf_lo(o0.x); ov[1] = bf_hi(o0.x); ov[2] = bf_lo(o0.y); ov[3] = bf_hi(o0.y); ov[4] = bf_lo(o0.z); ov[5] = bf_hi(o0.z); ov[6] = bf_lo(o0.w); ov[7] = bf_hi(o0.w);
        ov[8] = bf_lo(o1.x); ov[9] = bf_hi(o1.x); ov[10] = bf_lo(o1.y); ov[11] = bf_hi(o1.y); ov[12] = bf_lo(o1.z); ov[13] = bf_hi(o1.z); ov[14] = bf_lo(o1.w); ov[15] = bf_hi(o1.w);
        float ss = 0.f;
#pragma unroll
        for (int i = 0; i < 16; ++i) ss += hv[i] * hv[i];
        ss = row16_sum(ss);
        const float rs = 1.0f / sqrtf(ss * (1.0f / 256.0f) + LN_EPS);
        float ov2[16];
#pragma unroll
        for (int i = 0; i < 16; ++i) ov2[i] = hv[i] * rs * gg[i >> 2][i & 3] * sigmoidf_(ov[i]);
        u32x4 w0; w0.x = cvt4_fp8(ov2[0], ov2[1], ov2[2], ov2[3]); w0.y = cvt4_fp8(ov2[4], ov2[5], ov2[6], ov2[7]); w0.z = cvt4_fp8(ov2[8], ov2[9], ov2[10], ov2[11]); w0.w = cvt4_fp8(ov2[12], ov2[13], ov2[14], ov2[15]);
        *(u32x4*)(ymix + (size_t)row * D + 1024 + 16 * lane) = w0;
    }
}

typedef int i32x4v __attribute__((ext_vector_type(4)));
constexpr int P6_TILE = 32768  , P6_TSTR = 1032  , P6_TLO = 16 * P6_TSTR * 2  , P6_RED = P6_TILE + 2 * P6_TLO, P6_HIST = P6_RED + 8 * 16 * 32 * 4, P6_LN1 = 16384;
__device__ __forceinline__ void p6_put(LAS unsigned char* tile, int row, int ch, f32x4 v) {
    const unsigned h0 = cvt_pk_bf16(v[0], v[1]), h1 = cvt_pk_bf16(v[2], v[3]);
    const unsigned l0 = cvt_pk_bf16(v[0] - bf_lo(h0), v[1] - bf_hi(h0)), l1 = cvt_pk_bf16(v[2] - bf_lo(h1), v[3] - bf_hi(h1));
    *(LAS u32x2*)(tile + row * (P6_TSTR * 2) + ch * 2) = (u32x2){h0, h1}; *(LAS u32x2*)(tile + P6_TLO + row * (P6_TSTR * 2) + ch * 2) = (u32x2){l0, l1};
}
__device__ __forceinline__ void phase6(const Args& a, LAS unsigned char* lds, int bid, int G, int tid) {
    const int lane = tid & 63, wave = tid >> 6;
    LAS float* s_sc = (LAS float*)lds; LAS float* s_sh = s_sc + 2048;
    LAS unsigned char* tile = lds + P6_TILE; LAS float* red = (LAS float*)(lds + P6_RED); LAS int* hist = (LAS int*)(lds + P6_HIST);
    LAS float* s_g1 = (LAS float*)(lds + P6_LN1); LAS float* s_b1 = s_g1 + 2048;
    const float* mod = (const float*)(a.ws + WS_MOD); const bf16_t* r = (const bf16_t*)(a.ws + WS_R); float* stat = (float*)(a.ws + WS_STAT); unsigned char* h2 = a.ws + WS_H8;
    const float* rw = a.in[I_RW];
    int* tok_e = (int*)(a.ws + WS_TOKE); float* tok_w = (float*)(a.ws + WS_TOKW); int* tok_p = (int*)(a.ws + WS_TOKP); int* wgcnt = (int*)(a.ws + WS_WGCNT);
    const float rb_l = a.in[I_RB][lane & 31];
    float bhi[2][4][2][4], blo[2][4][2][4];
    { const u32x4* tb = (const u32x4*)(a.ws + WS_WRT) + (size_t)(wave * 16) * 2 * 64 + lane;
#pragma unroll
      for (int c = 0; c < 2; ++c)
#pragma unroll
          for (int ks = 0; ks < 4; ++ks)
#pragma unroll
              for (int h = 0; h < 2; ++h) { const int f = (c * 4 + ks) * 2 + h; const u32x4 hv_ = tb[(f * 2) * 64], lv_ = tb[(f * 2 + 1) * 64];
#pragma unroll
                  for (int q = 0; q < 4; ++q) { asm volatile("v_accvgpr_write_b32 %0, %1" : "=a"(bhi[c][ks][h][q]) : "v"(hv_[q])); asm volatile("v_accvgpr_write_b32 %0, %1" : "=a"(blo[c][ks][h][q]) : "v"(lv_[q])); }
                  if (h == 1) asm volatile("" ::: "memory"); } }
    for (int p = bid; p < T / 128; p += G) {
        const int b = (p * 128) / SEQ;
        __syncthreads();
        { int l_; asm volatile("v_mbcnt_lo_u32_b32 %0, -1, 0\n\tv_mbcnt_hi_u32_b32 %0, -1, %0" : "=v"(l_)); const int t0 = __builtin_amdgcn_readfirstlane(wave) * 64 + l_;
          for (int i = t0; i < 2048; i += 512) { s_sh[i] = mod[b * 12288 + 6144 + i]; s_sc[i] = 1.0f + mod[b * 12288 + 8192 + i]; s_g1[i] = a.in[I_LN1G][i]; s_b1[i] = a.in[I_LN1B][i]; } }
        __syncthreads();
        u32x2 raw[2][8];
#pragma unroll
        for (int rr = 0; rr < 2; ++rr) { const u32x2* xr = (const u32x2*)(r + (size_t)(p * 128 + 2 * wave + rr) * D) + lane;
#pragma unroll
            for (int j = 0; j < 8; ++j) raw[rr][j] = xr[64 * j]; }
        for (int tl = 0; tl < 8; ++tl) {
            f32x4 hc1[2][4];
#pragma unroll
            for (int rr = 0; rr < 2; ++rr) {
                const int row = p * 128 + tl * 16 + 2 * wave + rr;
                f32x4 v[8]; float s = 0.f;
#pragma unroll
                for (int j = 0; j < 8; ++j) { const u32x2 rv = raw[rr][j]; v[j] = (f32x4){bf_lo(rv.x), bf_hi(rv.x), bf_lo(rv.y), bf_hi(rv.y)}; s += (v[j][0] + v[j][1]) + (v[j][2] + v[j][3]); }
                float mean = wave_sum(s) * (1.0f / D), s2 = 0.f;
#pragma unroll
                for (int j = 0; j < 8; ++j) { v[j] = v[j] - mean; s2 += (v[j][0] * v[j][0] + v[j][1] * v[j][1]) + (v[j][2] * v[j][2] + v[j][3] * v[j][3]); }
                float rstd = 1.0f / sqrtf(wave_sum(s2) * (1.0f / D) + LN_EPS);
                if (lane == 0) *(f32x2*)(stat + (size_t)row * 2) = (f32x2){mean, rstd};
                s = 0.f;
#pragma unroll
                for (int j = 0; j < 8; ++j) { const f32x4 gq = *(const LAS f32x4*)(s_g1 + 4 * lane + 256 * j), bq = *(const LAS f32x4*)(s_b1 + 4 * lane + 256 * j);
                    v[j] = v[j] * rstd * gq + bq; s += (v[j][0] + v[j][1]) + (v[j][2] + v[j][3]); }
                mean = wave_sum(s) * (1.0f / D); s2 = 0.f;
#pragma unroll
                for (int j = 0; j < 8; ++j) { v[j] = v[j] - mean; s2 += (v[j][0] * v[j][0] + v[j][1] * v[j][1]) + (v[j][2] * v[j][2] + v[j][3] * v[j][3]); }
                rstd = 1.0f / sqrtf(wave_sum(s2) * (1.0f / D) + LN_EPS);
                unsigned* o4 = (unsigned*)(h2 + (size_t)row * D) + lane;
#pragma unroll
                for (int j = 0; j < 8; ++j) { const f32x4 sc = *(const LAS f32x4*)(s_sc + 4 * lane + 256 * j), sh = *(const LAS f32x4*)(s_sh + 4 * lane + 256 * j);
                    const f32x4 hq = v[j] * rstd * sc + sh; o4[64 * j] = cvt4_fp8(hq[0], hq[1], hq[2], hq[3]);
                    if (j < 4) p6_put(tile, 2 * wave + rr, 4 * lane + 256 * j, hq); else hc1[rr][j - 4] = hq; }
                asm volatile("" ::: "memory");
            }
            {
                const int tn = tl < 7 ? tl + 1 : tl;
#pragma unroll
                for (int rr = 0; rr < 2; ++rr) { const u32x2* xr = (const u32x2*)(r + (size_t)(p * 128 + tn * 16 + 2 * wave + rr) * D) + lane;
#pragma unroll
                    for (int j = 0; j < 8; ++j) raw[rr][j] = xr[64 * j]; }
            }
            f32x4 acc0 = (f32x4){0.f, 0.f, 0.f, 0.f}, acc1 = (f32x4){0.f, 0.f, 0.f, 0.f};
#pragma unroll
            for (int c = 0; c < 2; ++c) {
                if (c == 1) {
                    __syncthreads();
#pragma unroll
                    for (int rr = 0; rr < 2; ++rr)
#pragma unroll
                        for (int jj = 0; jj < 4; ++jj) p6_put(tile, 2 * wave + rr, 4 * lane + 256 * jj, hc1[rr][jj]);
                }
                __syncthreads();
                const LAS unsigned char* ap = tile + (lane & 15) * (P6_TSTR * 2) + (128 * wave + 8 * (lane >> 4)) * 2;
#pragma unroll
                for (int ks = 0; ks < 4; ++ks) { const bf16x8 ah = *(const LAS bf16x8*)(ap + 64 * ks), al = *(const LAS bf16x8*)(ap + P6_TLO + 64 * ks);
#pragma unroll
                    for (int h = 0; h < 2; ++h) {
#pragma unroll
                        for (int q = 0; q < 4; ++q) asm volatile("" : "+a"(bhi[c][ks][h][q]), "+a"(blo[c][ks][h][q]));
                        const bf16x8 bh = __builtin_bit_cast(bf16x8, (f32x4){bhi[c][ks][h][0], bhi[c][ks][h][1], bhi[c][ks][h][2], bhi[c][ks][h][3]});
                        const bf16x8 bl = __builtin_bit_cast(bf16x8, (f32x4){blo[c][ks][h][0], blo[c][ks][h][1], blo[c][ks][h][2], blo[c][ks][h][3]});
                        f32x4& ac = h ? acc1 : acc0;
                        ac = MFMA16(ah, bh, ac); ac = MFMA16(ah, bl, ac); ac = MFMA16(al, bh, ac); } }
            }
#pragma unroll
            for (int q = 0; q < 4; ++q) { red[(wave * 16 + 4 * (lane >> 4) + q) * 32 + (lane & 15)] = acc0[q]; red[(wave * 16 + 4 * (lane >> 4) + q) * 32 + 16 + (lane & 15)] = acc1[q]; }
            __syncthreads();
            float mylog = rb_l;
#pragma unroll
            for (int w = 0; w < 8; ++w) mylog += red[(w * 16 + 2 * wave + (lane >> 5)) * 32 + (lane & 31)];
            float cur = mylog; float tv[4]; int ti[4];
#pragma unroll
            for (int k = 0; k < 4; ++k) {
                float bv = cur; int bi = lane & 31;
#define P6_AM(ctrl_) do { const float ov = __int_as_float(__builtin_amdgcn_update_dpp(0, __float_as_int(bv), ctrl_, 0xF, 0xF, true)); const int oi = __builtin_amdgcn_update_dpp(0, bi, ctrl_, 0xF, 0xF, true); \
                    const bool tk_ = (ov > bv) | ((ov == bv) & (oi < bi)); bv = tk_ ? ov : bv; bi = tk_ ? oi : bi; } while (0)
                P6_AM(0xB1); P6_AM(0x4E); P6_AM(0x141); P6_AM(0x140);
#undef P6_AM
                { const auto rv = __builtin_amdgcn_permlane16_swap(__float_as_uint(bv), __float_as_uint(bv), false, false); const auto ri = __builtin_amdgcn_permlane16_swap((unsigned)bi, (unsigned)bi, false, false);
                  const float v0 = __uint_as_float(rv[0]), v1 = __uint_as_float(rv[1]); const int i0 = (int)ri[0], i1 = (int)ri[1];
                  const bool tk_ = (v1 > v0) | ((v1 == v0) & (i1 < i0)); bv = tk_ ? v1 : v0; bi = tk_ ? i1 : i0; }
                tv[k] = bv; ti[k] = bi; if ((lane & 31) == bi) cur = -3.0e38f;
            }
            const float e1 = __expf(tv[1] - tv[0]), e2 = __expf(tv[2] - tv[0]), e3 = __expf(tv[3] - tv[0]); const float inv = 1.0f / (1.0f + e1 + e2 + e3);
            if ((lane & 31) < 4) {
                const int k = lane & 3, rt = tl * 16 + 2 * wave + (lane >> 5), row = p * 128 + rt;
                const int ee = (k == 0) ? ti[0] : (k == 1) ? ti[1] : (k == 2) ? ti[2] : ti[3];
                const float ww = ((k == 0) ? 1.0f : (k == 1) ? e1 : (k == 2) ? e2 : e3) * inv;
                tok_e[row * 4 + k] = ee; tok_w[row * 4 + k] = ww; hist[rt * 4 + k] = ee;
            }
        }
        __syncthreads();
        if (wave == 0) {
            int base = 0;
            for (int ch = 0; ch < 8; ++ch) {
                const int ee = hist[ch * 64 + lane];
                const int pbase = __shfl(base, ee);
                unsigned long long mym = 0ull;
                for (int e = 0; e < 32; ++e) { const unsigned long long m = __ballot(ee == e); if (ee == e) mym = m; if (lane == e) base += __popcll(m); }
                const int rank = __popcll(mym & ((1ull << lane) - 1ull));
                tok_p[p * 512 + ch * 64 + lane] = pbase + rank;
            }
            if (lane < 32) wgcnt[p * 32 + lane] = base;
        }
    }
}

__device__ __forceinline__ void phase7(const Args& a, LAS unsigned char* lds, int bid, int G, int tid) {
    LAS int* pre = (LAS int*)lds;
    LAS int* tot = pre + 8192;
    LAS int* pst = tot + 32;
    const int* wgcnt = (const int*)(a.ws + WS_WGCNT); const int* tok_e = (const int*)(a.ws + WS_TOKE); int* tok_p = (int*)(a.ws + WS_TOKP);
    int* row_tok = (int*)(a.ws + WS_ROWTOK); int* tile_e = (int*)(a.ws + WS_TILEE);
    __syncthreads();
    for (int i = tid; i < 8192; i += 512) pre[i] = wgcnt[i];
    __syncthreads();
    {
        LAS int* seg = pst + 64;
        const int e = tid & 31, sg = tid >> 5; int run = 0;
        for (int w = 16 * sg; w < 16 * sg + 16; ++w) { const int c = pre[w * 32 + e]; pre[w * 32 + e] = run; run += c; }
        seg[sg * 32 + e] = run;
        __syncthreads();
        if (tid < 32) { int r2 = 0; for (int q = 0; q < 16; ++q) { const int c = seg[q * 32 + tid]; seg[q * 32 + tid] = r2; r2 += c; } tot[tid] = r2; }
        __syncthreads();
        const int base = seg[sg * 32 + e];
        for (int w = 16 * sg; w < 16 * sg + 16; ++w) pre[w * 32 + e] += base;
    }
    __syncthreads();
    if (tid == 0) { int run = 0; for (int e = 0; e < 32; ++e) { pst[e] = run; run += (tot[e] + 255) & ~255; } pst[32] = run; }
    __syncthreads();
    for (int p = bid; p < T / 128; p += G) {
        const int t = p * 128 + (tid >> 2), k = tid & 3, e = tok_e[t * 4 + k], lp = tok_p[t * 4 + k];
        const int slot = pst[e] + pre[p * 32 + e] + lp;
        row_tok[slot] = t; tok_p[t * 4 + k] = slot;
    }
    if (bid == 0) {
        for (int e = 0; e < 32; ++e) { const int s0 = pst[e] + tot[e], s1 = pst[e + 1]; for (int s = s0 + tid; s < s1; s += 512) row_tok[s] = 0; }
        const int ntl = pst[32] >> 8;
        for (int i = tid; i < ntl; i += 512) { int e = 0; for (int q = 1; q < 32; ++q) if ((pst[q] >> 8) <= i) e = q; tile_e[i] = e; }
        if (tid == 0) tile_e[1024] = ntl;
    }
}

__device__ __forceinline__ void phase10(const Args& a, LAS unsigned char* lds, int bid, int G, int tid) {
    const int lane = tid & 63, wave = tid >> 6;
    const float* mod = (const float*)(a.ws + WS_MOD); const bf16_t* rr = (const bf16_t*)(a.ws + WS_R); const float* stat = (const float*)(a.ws + WS_STAT); const unsigned char* yb = a.ws + WS_YB;
    const float* tok_w = (const float*)(a.ws + WS_TOKW); const int* tok_s = (const int*)(a.ws + WS_TOKP);
    LAS float* s_g2 = (LAS float*)lds; LAS float* s_lg = s_g2 + 2048; LAS float* s_lb = s_lg + 2048; LAS float* s_g1 = s_lb + 2048; LAS float* s_b1 = s_g1 + 2048;
    for (int p = bid; p < T / 128; p += G) {
        const int b = (p * 128) / SEQ;
        __syncthreads();
        for (int i = tid; i < 2048; i += 512) { s_g2[i] = mod[(size_t)b * 12288 + 10240 + i]; s_lg[i] = a.in[I_LN2G][i]; s_lb[i] = a.in[I_LN2B][i]; s_g1[i] = ALPHA * a.in[I_LN1G][i]; s_b1[i] = ALPHA * a.in[I_LN1B][i]; }
        __syncthreads();
        int nslot[4]; float nw[4]; f32x2 nst = *(const f32x2*)(stat + (size_t)(p * 128 + wave) * 2);
#pragma unroll
        for (int k = 0; k < 4; ++k) { nslot[k] = tok_s[(p * 128 + wave) * 4 + k]; nw[k] = tok_w[(p * 128 + wave) * 4 + k]; }
        for (int r = wave; r < 128; r += 8) {
            const int row = p * 128 + r;
            int slot[4]; float wk4[4];
#pragma unroll
            for (int k = 0; k < 4; ++k) { slot[k] = __builtin_amdgcn_readfirstlane(nslot[k]); wk4[k] = __uint_as_float(__builtin_amdgcn_readfirstlane(__float_as_uint(nw[k]))) * 0.125f; }
            const float mean1 = nst[0], rstd1 = nst[1];
            { const int rn = r + 8 < 128 ? r + 8 : r; nst = *(const f32x2*)(stat + (size_t)(p * 128 + rn) * 2);
#pragma unroll
              for (int k = 0; k < 4; ++k) { nslot[k] = tok_s[(p * 128 + rn) * 4 + k]; nw[k] = tok_w[(p * 128 + rn) * 4 + k]; } }
            float acc[32];
#pragma unroll
            for (int i = 0; i < 32; ++i) acc[i] = 0.f;
#pragma unroll
            for (int hf = 0; hf < 2; ++hf) {
#pragma unroll
                for (int k = 0; k < 4; ++k) { const u32x2* yp = (const u32x2*)(yb + (size_t)slot[k] * D) + lane; const float w = wk4[k];
#pragma unroll
                    for (int j = 2 * hf; j < 2 * hf + 2; ++j) { const u32x2 v = yp[64 * j];
                        const f32x2 p0 = __builtin_amdgcn_cvt_pk_f32_fp8((int)v.x, false), p1 = __builtin_amdgcn_cvt_pk_f32_fp8((int)v.x, true), p2 = __builtin_amdgcn_cvt_pk_f32_fp8((int)v.y, false), p3 = __builtin_amdgcn_cvt_pk_f32_fp8((int)v.y, true);
                        acc[8 * j + 0] += w * p0[0]; acc[8 * j + 1] += w * p0[1]; acc[8 * j + 2] += w * p1[0]; acc[8 * j + 3] += w * p1[1];
                        acc[8 * j + 4] += w * p2[0]; acc[8 * j + 5] += w * p2[1]; acc[8 * j + 6] += w * p3[0]; acc[8 * j + 7] += w * p3[1]; } }
                asm volatile("" ::: "memory");
            }
            float s = 0.f;
#pragma unroll
            for (int j = 0; j < 4; ++j) {
                const int ch = 8 * lane + 512 * j;
                const u32x4 xv = *(const u32x4*)(rr + (size_t)row * D + ch);
                const f32x4 xa = ((f32x4){bf_lo(xv.x), bf_hi(xv.x), bf_lo(xv.y), bf_hi(xv.y)} - mean1) * rstd1, xb = ((f32x4){bf_lo(xv.z), bf_hi(xv.z), bf_lo(xv.w), bf_hi(xv.w)} - mean1) * rstd1;
                const f32x4 ga = *(const LAS f32x4*)(s_g2 + ch), gb = *(const LAS f32x4*)(s_g2 + ch + 4);
                const f32x4 la = *(const LAS f32x4*)(s_g1 + ch), lb = *(const LAS f32x4*)(s_g1 + ch + 4), ca = *(const LAS f32x4*)(s_b1 + ch), cb = *(const LAS f32x4*)(s_b1 + ch + 4);
#pragma unroll
                for (int i = 0; i < 4; ++i) { acc[8 * j + i] = (xa[i] * la[i] + ca[i]) + ga[i] * acc[8 * j + i]; acc[8 * j + 4 + i] = (xb[i] * lb[i] + cb[i]) + gb[i] * acc[8 * j + 4 + i]; }
#pragma unroll
                for (int i = 0; i < 8; ++i) s += acc[8 * j + i];
            }
            const float mean = wave_sum(s) * (1.0f / D); float s2 = 0.f;
#pragma unroll
            for (int i = 0; i < 32; ++i) { acc[i] -= mean; s2 += acc[i] * acc[i]; }
            const float rstd = 1.0f / sqrtf(wave_sum(s2) * (1.0f / D) + LN_EPS);
#pragma unroll
            for (int j = 0; j < 4; ++j) {
                const int ch = 8 * lane + 512 * j;
                const f32x4 ga = *(const LAS f32x4*)(s_lg + ch), gb = *(const LAS f32x4*)(s_lg + ch + 4), ba = *(const LAS f32x4*)(s_lb + ch), bb = *(const LAS f32x4*)(s_lb + ch + 4);
                f32x4 oa, ob;
#pragma unroll
                for (int i = 0; i < 4; ++i) { oa[i] = acc[8 * j + i] * rstd * ga[i] + ba[i]; ob[i] = acc[8 * j + 4 + i] * rstd * gb[i] + bb[i]; }
                *(f32x4*)(a.out + (size_t)row * D + ch) = oa; *(f32x4*)(a.out + (size_t)row * D + ch + 4) = ob;
            }
        }
    }
}
__device__ __forceinline__ int fresh_tid(int wave_s) { int l; asm volatile("v_mbcnt_lo_u32_b32 %0, -1, 0\n\tv_mbcnt_hi_u32_b32 %0, -1, %0" : "=v"(l)); return wave_s * 64 + l; }
__global__ void __launch_bounds__(512, 2) hybrid_fwd(Args args) {
    extern __shared__ __attribute__((aligned(16))) unsigned char lds_raw[];
    LAS unsigned char* lds = (LAS unsigned char*)lds_raw;
    const int bid = blockIdx.x, G = gridDim.x;
    const int wave_s = __builtin_amdgcn_readfirstlane((int)threadIdx.x >> 6);
#define TID() fresh_tid(wave_s)
    const int vcu = (G % 8 == 0) ? (bid % 8) * (G / 8) + bid / 8 : bid;
    volatile LAS unsigned* MISC = (volatile LAS unsigned*)(lds + MISC_OFF);
    { const int tid = TID(); if (tid < 32) MISC[tid] = 0u; }
    __syncthreads();
    const int lo = args.ph_lo, hi = args.ph_hi;
    unsigned* barw = (unsigned*)(args.ws + WS_CTL) + CW_BAR;
    XcdBarrier bar; bar.bar = barw; bar.x = 0; bar.st = MISC + 8;
    if (hi - lo > 1) bar = xcd_barrier_post(barw, MISC + 8, TID());
#ifndef PHMASK
#define PHMASK 0x7ff
#endif
#ifndef REPMASK
#define REPMASK 0
#endif
#define IN(k) (((PHMASK >> (k)) & 1) && lo <= (k) && (k) < hi)
#define REP(k) for (int rep_ = 0; rep_ < (((REPMASK >> (k)) & 1) ? 2 : 1); ++rep_)
#define SEAM(k) do { if (IN(k) && IN((k) + 1)) xcd_barrier(bar, TID()); } while (0)

    if (IN(0)) REP(0) { phase0(args, lds, bid, G, TID()); } SEAM(0);
    if (IN(1)) REP(1) { phase1(args, lds, bid, G, TID()); } SEAM(1);
    if (IN(2)) REP(2) {
        { pg8::ProbPlain8 P{args.ws + WS_HF8, args.ws + WS_WTIN, D, SCALE_ONE, SCALE_W};
          pg8::TileOrder S; S.init(T / 256, 8, G, bid);
          pg8::EpiGLU E{(bf16_t*)(args.ws + WS_Z), args.in[I_BIN]};
          pg8::gemm_phase<pg8::EpiGLU, pg8::ProbPlain8>(lds, P, S, E, TID()); }
        { pg8::ProbPlain8 P{args.ws + WS_HF8, args.ws + WS_WTIN + (size_t)2048 * D, D, SCALE_ONE, SCALE_W};
          pg8::TileOrder S; S.init(T / 256, 12, G, bid);
          pg8::EpiZ E{(bf16_t*)(args.ws + WS_Z), args.in[I_BIN], 1024, 2048, 2};
          pg8::gemm_phase<pg8::EpiZ, pg8::ProbPlain8>(lds, P, S, E, TID()); }
    } SEAM(2);
    if (IN(3)) REP(3) {
        REP(12) for (int u = vcu; u < 256; u += G) { __syncthreads(); mlstm_chain(args, lds, u >> 3, u & 7, TID()); }
        __syncthreads();
        REP(11) conv_phase(args, lds, bid, G, TID());
    } SEAM(3);
    if (IN(4)) REP(4) { phase_postnorm(args, bid, G, TID()); } SEAM(4);
    if (IN(5)) REP(5) {
        pg8::ProbPlain8 P{args.ws + WS_YMIX, args.ws + WS_WTOUT, D, SCALE_ONE, SCALE_W};
        pg8::TileOrder S; S.init(T / 256, D / 256, G, bid);
        pg8::EpiR E{(bf16_t*)(args.ws + WS_R), args.in[I_X], (const float*)(args.ws + WS_MOD)};
        pg8::gemm_phase<pg8::EpiR, pg8::ProbPlain8>(lds, P, S, E, TID());
    } SEAM(5);
    if (IN(6)) REP(6) { phase6(args, lds, bid, G, TID()); } SEAM(6);
    if (IN(7)) { phase7(args, lds, bid, G, TID()); } SEAM(7);
    if (IN(8)) REP(8) {
        const int* tile_e = (const int*)(args.ws + WS_TILEE);
        const int ntl = __builtin_amdgcn_readfirstlane(tile_e[1024]);
        pg8::ProbGather P{args.ws + WS_H8, args.ws + WS_WTGU, D, 4096, tile_e, (const int*)(args.ws + WS_ROWTOK), SCALE_ONE, SCALE_W};
        pg8::TileOrder S; S.init(ntl, 16, G, bid);
        pg8::EpiAct E{args.ws + WS_ACT, args.in[I_BG], args.in[I_BU], tile_e};
        pg8::gemm_phase<pg8::EpiAct, pg8::ProbGather>(lds, P, S, E, TID());
    } SEAM(8);
    if (IN(9)) REP(9) {
        const int* tile_e = (const int*)(args.ws + WS_TILEE);
        const int ntl = __builtin_amdgcn_readfirstlane(tile_e[1024]);
        pg8::ProbExpert P{args.ws + WS_ACT, args.ws + WS_WTDN, D, 2048, tile_e, SCALE_ACT8, SCALE_W};
        pg8::TileOrder S; S.init(ntl, 8, G, bid);
        pg8::EpiY E{args.ws + WS_YB, args.in[I_BD], tile_e};
        pg8::gemm_phase<pg8::EpiY, pg8::ProbExpert>(lds, P, S, E, TID());
    } SEAM(9);
    if (IN(10)) REP(10) { phase10(args, lds, bid, G, TID()); }
#undef TID
#undef IN
#undef SEAM
}

#ifndef MK_PER_PHASE
#define MK_PER_PHASE 0
#endif
extern "C" void kernel_launch(void* const* d_in, const int* in_sizes, int n_in, void* d_out, int out_size, void* d_ws, size_t ws_size, hipStream_t stream) {
    static int grid = 0;
    if (grid == 0) {
        if (n_in != 24 || out_size != T * D || ws_size < WS_END) { fprintf(stderr, "kernel_launch: unexpected shapes (n_in %d, out %d, ws %zu); nothing launched\n", n_in, out_size, ws_size); grid = -1; return; }
        int dev = 0, cus = 0;
        if (hipGetDevice(&dev) != hipSuccess || hipDeviceGetAttribute(&cus, hipDeviceAttributeMultiprocessorCount, dev) != hipSuccess) { grid = -1; return; }
        if (hipFuncSetAttribute((const void*)hybrid_fwd, hipFuncAttributeMaxDynamicSharedMemorySize, LDS_BYTES) != hipSuccess) { fprintf(stderr, "kernel_launch: hipFuncSetAttribute failed\n"); grid = -1; return; }
        int per_cu = 0;
        if (hipOccupancyMaxActiveBlocksPerMultiprocessor(&per_cu, (const void*)hybrid_fwd, 512, LDS_BYTES) != hipSuccess || per_cu < 1) fprintf(stderr, "kernel_launch: occupancy query says %d\n", per_cu);
        (void)hipGetLastError();
        grid = cus;
    }
    if (grid < 0) return;
    (void)in_sizes;
    (void)hipMemsetAsync((char*)d_ws + WS_CTL, 0, CTL_ZERO_BYTES, stream);
    Args a{};
    for (int i = 0; i < 24; ++i) a.in[i] = (const float*)d_in[i];
    a.out = (float*)d_out; a.ws = (unsigned char*)d_ws;
#if MK_PER_PHASE
    for (int p = 0; p < NPH; ++p) { a.ph_lo = p; a.ph_hi = p + 1; hipLaunchKernelGGL(hybrid_fwd, dim3(grid), dim3(512), LDS_BYTES, stream, a); }
#else
    a.ph_lo = 0; a.ph_hi = NPH; hipLaunchKernelGGL(hybrid_fwd, dim3(grid), dim3(512), LDS_BYTES, stream, a);
#endif
}
```

```cpp
#include <hip/hip_runtime.h>
#include <cstdio>
#include <cstdint>

#define LAS __attribute__((address_space(3)))
typedef unsigned short bf16_t;
typedef short bf16x8 __attribute__((ext_vector_type(8)));
typedef short s16x4 __attribute__((ext_vector_type(4)));
typedef short v4i16_t __attribute__((ext_vector_type(4)));
typedef float f32x4 __attribute__((ext_vector_type(4)));
typedef float f32x2 __attribute__((ext_vector_type(2)));
typedef unsigned u32x4 __attribute__((ext_vector_type(4)));
typedef unsigned u32x2 __attribute__((ext_vector_type(2)));

constexpr int D = 2048, BATCH = 8, SEQ = 4096, T = BATCH * SEQ;
constexpr int ZW = 4096;
constexpr int DIN = 5128, DINP = 5120;
constexpr int NE = 32;
constexpr float LN_EPS = 1e-5f;
constexpr float ALPHA = 1.189207115002721f;
constexpr float KSCALE = 0.08838834764831845f;
constexpr int MAXTILES = 544;
constexpr int NPH = 11;

constexpr size_t MiB = 1u << 20;
constexpr size_t WS_CTL = 0, CTL_ZERO_BYTES = 1 * MiB;
constexpr size_t WS_MOD = 1 * MiB;
constexpr size_t WS_GATES = 2 * MiB;
constexpr size_t WS_WRT = 3 * MiB;
constexpr size_t WS_TOKE = 4 * MiB;
constexpr size_t WS_TOKW = 5 * MiB;
constexpr size_t WS_TOKP = 6 * MiB;
constexpr size_t WS_WGCNT = 7 * MiB;
constexpr size_t WS_ROWTOK = 8 * MiB;
constexpr size_t WS_TILEE = 9 * MiB;
constexpr size_t WS_WTIN = 16 * MiB;
constexpr size_t WS_WTOUT = 36 * MiB;
constexpr size_t WS_WTIN8 = 40 * MiB;
constexpr size_t WS_HF8 = 560 * MiB;
constexpr size_t WS_WTGU = 48 * MiB;
constexpr size_t WS_WTDN = 304 * MiB;
constexpr size_t WS_H = 432 * MiB;
constexpr size_t WS_H8 = 432 * MiB;
constexpr size_t WS_STAT = 560 * MiB;
constexpr size_t WS_Z = 816 * MiB;
constexpr size_t WS_YMIX = 1136 * MiB;
constexpr size_t WS_HBUF = 1264 * MiB;
constexpr size_t WS_R = 624 * MiB;
constexpr size_t WS_ACT = 816 * MiB;
constexpr size_t WS_YB = 1088 * MiB;
constexpr size_t WS_SCAL = 1632 * MiB;
constexpr size_t WS_END = 1664 * MiB;
static_assert(WS_ACT + (size_t)MAXTILES * 256 * 2048 <= WS_YB && WS_YB + (size_t)MAXTILES * 256 * 2048 * 2 <= WS_END, "overlay map");
constexpr int SCALE_ONE = 0x7F7F7F7F, SCALE_W = 0x79797979, SCALE_ACT = 0x7D7D7D7D, SCALE_ACT8 = 0x80808080;
constexpr int CW_BAR = 4096;

constexpr int LDS_BYTES = 147456;
constexpr int MISC_OFF = 131072 + 8192 + 4096;

typedef __bf16 bf16x2_t __attribute__((ext_vector_type(2)));
__device__ __forceinline__ unsigned cvt_pk_bf16(float lo, float hi) { const f32x2 v = {lo, hi}; const bf16x2_t b = __builtin_convertvector(v, bf16x2_t); return __builtin_bit_cast(unsigned, b); }
__device__ __forceinline__ unsigned cvt4_fp8(float a, float b, float c, float d) { int r = __builtin_amdgcn_cvt_pk_fp8_f32(a, b, 0, false); r = __builtin_amdgcn_cvt_pk_fp8_f32(c, d, r, true); return (unsigned)r; }
__device__ __forceinline__ float bf_lo(unsigned u) { return __uint_as_float(u << 16); }
__device__ __forceinline__ float bf_hi(unsigned u) { return __uint_as_float(u & 0xffff0000u); }
__device__ __forceinline__ float dpp_add(float v, const int ctrl_sel) {
    int r;
    if (ctrl_sel == 0) r = __builtin_amdgcn_update_dpp(0, __float_as_int(v), 0xB1, 0xF, 0xF, true);
    else if (ctrl_sel == 1) r = __builtin_amdgcn_update_dpp(0, __float_as_int(v), 0x4E, 0xF, 0xF, true);
    else if (ctrl_sel == 2) r = __builtin_amdgcn_update_dpp(0, __float_as_int(v), 0x141, 0xF, 0xF, true);
    else r = __builtin_amdgcn_update_dpp(0, __float_as_int(v), 0x140, 0xF, 0xF, true);
    return v + __int_as_float(r);
}
__device__ __forceinline__ float row16_sum(float v) { v = dpp_add(v, 0); v = dpp_add(v, 1); v = dpp_add(v, 2); v = dpp_add(v, 3); return v; }
__device__ __forceinline__ float wave_sum(float v) {
    v = row16_sum(v);
    { const auto r = __builtin_amdgcn_permlane16_swap(__float_as_uint(v), __float_as_uint(v), false, false); v = __uint_as_float(r[0]) + __uint_as_float(r[1]); }
    { const auto r = __builtin_amdgcn_permlane32_swap(__float_as_uint(v), __float_as_uint(v), false, false); v = __uint_as_float(r[0]) + __uint_as_float(r[1]); }
    return v;
}
__device__ __forceinline__ float sigmoidf_(float x) { return __builtin_amdgcn_rcpf(1.0f + __builtin_amdgcn_exp2f(x * -1.4426950408889634f)); }
#define LDS_WAIT() asm volatile("s_waitcnt lgkmcnt(0)" ::: "memory")

namespace pg8 {
constexpr int BM = 256, BK = 64, HALF = 128, HTB = HALF * BK * 2, STAGE_BYTES = 8 * HTB, NXCD = 8, WGM = 8;
__host__ __device__ __forceinline__ int lds_byte(int r, int c) { const int st = (r >> 4) * 2 + (c >> 5), rr = r & 15, cc = c & 31, ob = rr * 64 + cc * 2; return st * 1024 + (ob ^ (((ob >> 9) & 1) << 5)); }
__host__ __device__ __forceinline__ void stage_rc(int b, int& R, int& C) { const int st = b / 1024, sb = b % 1024, swz = sb ^ (((sb >> 9) & 1) << 5); R = (st >> 1) * 16 + swz / 64; C = (st & 1) * 32 + (swz % 64) / 2; }
__host__ __device__ __forceinline__ int perm32(int rho) { const int n = rho >> 4, i = rho & 15; return 8 * (i >> 2) + 4 * n + (i & 3); }

typedef int i32x4 __attribute__((ext_vector_type(4)));
typedef int i32x8 __attribute__((ext_vector_type(8)));
__device__ __forceinline__ i32x8 cat_i8(bf16x8 a, bf16x8 b) { return __builtin_shufflevector(__builtin_bit_cast(i32x4, a), __builtin_bit_cast(i32x4, b), 0, 1, 2, 3, 4, 5, 6, 7); }
__device__ __forceinline__ void mfma8(f32x4& acc, i32x8 a, i32x8 b, int sa, int sb) {
    asm volatile("v_mfma_scale_f32_16x16x128_f8f6f4 %0, %1, %2, %0, %3, %4 op_sel_hi:[0,0,0]" : "+a"(acc) : "v"(a), "v"(b), "v"(sa), "v"(sb));
}
__device__ __forceinline__ void mfma16a(f32x4& acc, bf16x8 a, bf16x8 b) { asm volatile("v_mfma_f32_16x16x32_bf16 %0, %1, %2, %0" : "+a"(acc) : "v"(a), "v"(b)); }
__device__ __forceinline__ void acc_settle(f32x4 (&acc)[2][2][4][2]) {
#pragma unroll
    for (int a = 0; a < 2; ++a)
#pragma unroll
        for (int b = 0; b < 2; ++b)
            asm volatile("s_nop 15\n\ts_nop 7" : "+a"(acc[a][b][0][0]), "+a"(acc[a][b][0][1]), "+a"(acc[a][b][1][0]), "+a"(acc[a][b][1][1]), "+a"(acc[a][b][2][0]), "+a"(acc[a][b][2][1]), "+a"(acc[a][b][3][0]), "+a"(acc[a][b][3][1]));
}
template <int OFF> __device__ __forceinline__ int aload1(const int* sbase, unsigned voff) { int v; asm volatile("global_load_dword %0, %1, %2 offset:%3" : "=&v"(v) : "v"(voff), "s"(sbase), "n"(OFF) : "memory"); return v; }
template <int OFF> __device__ __forceinline__ f32x4 aload4(const float* sbase, unsigned voff) { f32x4 v; asm volatile("global_load_dwordx4 %0, %1, %2 offset:%3" : "=&v"(v) : "v"(voff), "s"(sbase), "n"(OFF) : "memory"); return v; }
struct Unit { int pm, pn, e; };
struct TileOrder {
    int nM, nN, nwg, G, c;
    __device__ void init(int nM_, int nN_, int G_, int c_) { nM = nM_; nN = nN_; nwg = nM * nN; G = G_; c = c_; }
    __device__ bool next(int i, Unit& u) const {
        const long L = (long)i * G + c; if (L >= nwg) return false;
        int wgid = (int)L; { const int q = nwg / NXCD, r = nwg % NXCD, xcd = wgid % NXCD, off = wgid / NXCD; wgid = (xcd < r ? xcd * (q + 1) : r * (q + 1) + (xcd - r) * q) + off; }
        const int nig = WGM * nN, gid = wgid / nig, fm = gid * WGM, gsz = (nM - fm) < WGM ? (nM - fm) : WGM;
        u.pm = __builtin_amdgcn_readfirstlane(fm + ((wgid % nig) % gsz)); u.pn = __builtin_amdgcn_readfirstlane((wgid % nig) / gsz); return true;
    }
};
struct ProbPlain {
    static constexpr bool GATHER = false, FP8 = false;
    const unsigned char* A; const unsigned char* Bt; int KB;
    __device__ __forceinline__ const char* a_base(const Unit& u) const { return (const char*)(A + (size_t)u.pm * BM * KB); }
    __device__ __forceinline__ const char* b_base(const Unit& u) const { return (const char*)(Bt + (size_t)u.pn * BM * KB); }
    static constexpr bool EXPERT = false;
    __device__ __forceinline__ int raw_e(const Unit&) const { return 0; }
    __device__ __forceinline__ const int* e_ptr(const Unit&) const { return nullptr; }
    __device__ __forceinline__ int raw_tok(const Unit&, int) const { return 0; }
    __device__ __forceinline__ const int* tok_base(const Unit&) const { return nullptr; }
    __device__ __forceinline__ int sa() const { return 0; }
    __device__ __forceinline__ int sb() const { return 0; }
};
struct ProbPlain8 {
    static constexpr bool GATHER = false, FP8 = true;
    const unsigned char* A; const unsigned char* Bt; int KB; int scale_a, scale_b;
    __device__ __forceinline__ const char* a_base(const Unit& u) const { return (const char*)(A + (size_t)u.pm * BM * KB); }
    __device__ __forceinline__ const char* b_base(const Unit& u) const { return (const char*)(Bt + (size_t)u.pn * BM * KB); }
    static constexpr bool EXPERT = false;
    __device__ __forceinline__ int raw_e(const Unit&) const { return 0; }
    __device__ __forceinline__ const int* e_ptr(const Unit&) const { return nullptr; }
    __device__ __forceinline__ int raw_tok(const Unit&, int) const { return 0; }
    __device__ __forceinline__ const int* tok_base(const Unit&) const { return nullptr; }
    __device__ __forceinline__ int sa() const { return scale_a; }
    __device__ __forceinline__ int sb() const { return scale_b; }
};
struct ProbExpert {
    static constexpr bool GATHER = false, FP8 = true;
    const unsigned char* A; const unsigned char* Bt; int KB; int nrows_e; const int* tile_e; int scale_a, scale_b;
    __device__ __forceinline__ const char* a_base(const Unit& u) const { return (const char*)(A + (size_t)u.pm * BM * KB); }
    __device__ __forceinline__ const char* b_base(const Unit& u) const { return (const char*)(Bt + ((size_t)u.e * nrows_e + (size_t)u.pn * BM) * KB); }
    static constexpr bool EXPERT = true;
    __device__ __forceinline__ int raw_e(const Unit& u) const { return tile_e[u.pm]; }
    __device__ __forceinline__ const int* e_ptr(const Unit& u) const { return tile_e + u.pm; }
    __device__ __forceinline__ int raw_tok(const Unit&, int) const { return 0; }
    __device__ __forceinline__ const int* tok_base(const Unit&) const { return nullptr; }
    __device__ __forceinline__ int sa() const { return scale_a; }
    __device__ __forceinline__ int sb() const { return scale_b; }
};
struct ProbGather {
    static constexpr bool GATHER = true, FP8 = true;
    const unsigned char* A; const unsigned char* Bt; int KB; int nrows_e; const int* tile_e; const int* row_tok; int scale_a, scale_b;
    __device__ __forceinline__ const char* a_base(const Unit&) const { return (const char*)A; }
    __device__ __forceinline__ const char* b_base(const Unit& u) const { return (const char*)(Bt + ((size_t)u.e * nrows_e + (size_t)u.pn * BM) * KB); }
    static constexpr bool EXPERT = true;
    __device__ __forceinline__ int raw_e(const Unit& u) const { return tile_e[u.pm]; }
    __device__ __forceinline__ const int* e_ptr(const Unit& u) const { return tile_e + u.pm; }
    __device__ __forceinline__ int raw_tok(const Unit& u, int r) const { return row_tok[u.pm * BM + r]; }
    __device__ __forceinline__ const int* tok_base(const Unit& u) const { return row_tok + u.pm * BM; }
    __device__ __forceinline__ int sa() const { return scale_a; }
    __device__ __forceinline__ int sb() const { return scale_b; }
};

template <class Epi, class Prob>
__device__ __forceinline__ void gemm_phase(LAS unsigned char* lds, const Prob& P, const TileOrder& S, const Epi& E, const int tid) {
    const int wid = __builtin_amdgcn_readfirstlane(tid >> 6), lane = tid & 63, wr = wid >> 2, wc = wid & 3, fr = lane & 15, fq = lane >> 4;
    const int KB = P.KB, nt = KB / 128;
    unsigned voffB[2], vc0[2], vc1[2], vn0[2], vn1[2]; int RA[2], CA[2];
    const size_t kstep = 128;
    const size_t hstep = (size_t)HALF * KB;
    const size_t bstep = Epi::PERM == 2 ? (size_t)32 * KB : hstep;
    const int sA = P.sa(), sB = P.sb(); (void)sA; (void)sB;
#pragma unroll
    for (int i = 0; i < 2; ++i) { int R, C; stage_rc(tid * 16 + i * 8192, R, C); const int Rb = Epi::PERM == 2 ? (64 * (R >> 5) + perm32(R & 31)) : Epi::PERM ? ((R & ~31) + perm32(R & 31)) : R;
        RA[i] = R; CA[i] = C; voffB[i] = (unsigned)(Rb * KB + C * 2);
        if constexpr (!Prob::GATHER) { vc0[i] = (unsigned)(R * KB + C * 2); vc1[i] = vc0[i] + (unsigned)hstep; vn0[i] = vc0[i]; vn1[i] = vc1[i]; } }
    const unsigned ldsw = (unsigned)wid * 1024u;
    const int aoff = lds_byte(wr * 64 + fr, fq * 8), boff = lds_byte(wc * 32 + fr, fq * 8);
#define PG8_SA(b, h) (((b) * 2 + (h)) * HTB)
#define PG8_SB(b, h) ((4 + (b) * 2 + (h)) * HTB)
#define PG8_STAGE(bufoff, gbase, voff) do { _Pragma("unroll") for (int _i = 0; _i < 2; ++_i) \
        __builtin_amdgcn_global_load_lds((const unsigned*)((const char*)(gbase) + (voff)[_i]), (LAS unsigned*)(lds + (bufoff) + ldsw + _i * 8192), 16, 0, 0); } while (0)
#define PG8_LDA(dst, b, h) do { _Pragma("unroll") for (int m = 0; m < 4; ++m) _Pragma("unroll") for (int k = 0; k < 2; ++k) dst[m][k] = *(const LAS bf16x8*)(lds + PG8_SA(b, h) + aoff + m * 2048 + k * 1024); } while (0)
#define PG8_LDB(dst, b, h) do { _Pragma("unroll") for (int n = 0; n < 2; ++n) _Pragma("unroll") for (int k = 0; k < 2; ++k) dst[n][k] = *(const LAS bf16x8*)(lds + PG8_SB(b, h) + boff + n * 2048 + k * 1024); } while (0)
#define PG8_MMA(ai, bj, At, Bt) do { __builtin_amdgcn_s_setprio(1); _Pragma("unroll") for (int m = 0; m < 4; ++m) _Pragma("unroll") for (int n = 0; n < 2; ++n) { \
        if constexpr (Prob::FP8) mfma8(acc[ai][bj][m][n], cat_i8(Bt[n][0], Bt[n][1]), cat_i8(At[m][0], At[m][1]), sB, sA); \
        else { _Pragma("unroll") for (int k = 0; k < 2; ++k) mfma16a(acc[ai][bj][m][n], Bt[n][k], At[m][k]); } } __builtin_amdgcn_s_setprio(0); } while (0)
#define PG8_WAIT_V(n) asm volatile("s_waitcnt vmcnt(" #n ")" ::: "memory")
#define PG8_WAIT_L(n) asm volatile("s_waitcnt lgkmcnt(" #n ")" ::: "memory")
#define PG8_BAR __builtin_amdgcn_s_barrier()
#define PG8_SCHED __builtin_amdgcn_sched_barrier(0)
    Unit cur, nxt, nx2; int ui = 0;
    if (!S.next(0, cur)) return;
    bool has_next = S.next(1, nxt);
    cur.e = __builtin_amdgcn_readfirstlane(P.raw_e(cur)); nxt.e = has_next ? __builtin_amdgcn_readfirstlane(P.raw_e(nxt)) : 0; nx2.e = 0;
    f32x4 acc[2][2][4][2]; f32x4 nb[2][2];
#pragma unroll
    for (int b = 0; b < 2; ++b)
#pragma unroll
        for (int n = 0; n < 2; ++n) { if constexpr (Epi::BIAS) nb[b][n] = *(const f32x4*)(E.bias_base(cur, wc, b) + 8 * fq + 4 * n); else nb[b][n] = (f32x4){0.f, 0.f, 0.f, 0.f}; }
#pragma unroll
    for (int a = 0; a < 2; ++a)
#pragma unroll
        for (int b = 0; b < 2; ++b)
#pragma unroll
            for (int m = 0; m < 4; ++m)
#pragma unroll
                for (int n = 0; n < 2; ++n) { if constexpr (Epi::BIAS) acc[a][b][m][n] = E.bias_xf(nb[b][n], b); else acc[a][b][m][n] = (f32x4){0.f, 0.f, 0.f, 0.f}; }
    bf16x8 At[4][2], B0[2][2], B1[2][2];
    const char* cA = P.a_base(cur); const char* cB = P.b_base(cur);
    if constexpr (Prob::GATHER) {
#pragma unroll
        for (int i = 0; i < 2; ++i) { vc0[i] = (unsigned)P.raw_tok(cur, RA[i]) * (unsigned)KB + (unsigned)CA[i] * 2u; vc1[i] = (unsigned)P.raw_tok(cur, HALF + RA[i]) * (unsigned)KB + (unsigned)CA[i] * 2u; }
    }
    PG8_STAGE(PG8_SB(0, 0), cB, voffB); PG8_STAGE(PG8_SB(0, 1), cB + bstep, voffB); PG8_STAGE(PG8_SA(0, 0), cA, vc0); PG8_STAGE(PG8_SA(0, 1), cA, vc1);
    if (wr == 1) PG8_BAR;
    PG8_WAIT_V(2); PG8_BAR;
    PG8_STAGE(PG8_SB(1, 0), cB + kstep, voffB); PG8_STAGE(PG8_SA(1, 0), cA + kstep, vc0); PG8_STAGE(PG8_SB(1, 1), cB + bstep + kstep, voffB);
    PG8_WAIT_V(6); PG8_BAR;
    int env = 0;
    for (;;) {
        const bool has2 = has_next && S.next(ui + 2, nx2);
        if constexpr (Prob::EXPERT) { if (has2) env = aload1<0>(P.e_ptr(nx2), 0u); }
        int rt0[2] = {0, 0}, rt1[2] = {0, 0};
        if constexpr (Prob::GATHER) { if (has_next) {
#pragma unroll
            for (int i = 0; i < 2; ++i) { rt0[i] = aload1<0>(P.tok_base(nxt), (unsigned)RA[i] * 4u); rt1[i] = aload1<HALF * 4>(P.tok_base(nxt), (unsigned)RA[i] * 4u); } } }
        if constexpr (Epi::BIAS) { if (has_next) { int l_; asm volatile("v_mbcnt_lo_u32_b32 %0, -1, 0\n\tv_mbcnt_hi_u32_b32 %0, -1, %0" : "=v"(l_));
#pragma unroll
            for (int b = 0; b < 2; ++b) { const float* bb = E.bias_base(nxt, wc, b); nb[b][0] = aload4<0>(bb, (unsigned)(l_ >> 4) * 32u); nb[b][1] = aload4<16>(bb, (unsigned)(l_ >> 4) * 32u); } } }
        const char* nA = has_next ? P.a_base(nxt) : cA; const char* nB = has_next ? P.b_base(nxt) : cB;
        for (int t = 0; t < nt; t += 2) {
            const bool last = (t == nt - 2);
            const char* a1 = cA + (size_t)(t + 1) * kstep;
            unsigned x0[2] = {vc0[0], vc0[1]}, x1[2] = {vc1[0], vc1[1]};
            if (last) {
                if constexpr (Prob::GATHER) {
                    if (has_next) {
                        asm volatile("; next unit's rows" : "+v"(rt0[0]), "+v"(rt0[1]), "+v"(rt1[0]), "+v"(rt1[1]));
#pragma unroll
                        for (int i = 0; i < 2; ++i) { vn0[i] = (unsigned)rt0[i] * (unsigned)KB + (unsigned)CA[i] * 2u; vn1[i] = (unsigned)rt1[i] * (unsigned)KB + (unsigned)CA[i] * 2u; }
                    } else {
#pragma unroll
                        for (int i = 0; i < 2; ++i) { vn0[i] = vc0[i]; vn1[i] = vc1[i]; }
                    }
                    x0[0] = vn0[0]; x0[1] = vn0[1]; x1[0] = vn1[0]; x1[1] = vn1[1];
                }
            }
            const char* a2 = last ? nA : cA + (size_t)(t + 2) * kstep; const char* b2 = last ? nB : cB + (size_t)(t + 2) * kstep;
            const char* a3 = a2 + kstep; const char* b3 = b2 + kstep;
            PG8_LDB(B0, 0, 0); PG8_LDB(B1, 0, 1); PG8_SCHED; PG8_LDA(At, 0, 0); PG8_STAGE(PG8_SA(1, 1), a1, vc1);
            PG8_WAIT_V(8); PG8_WAIT_L(0); PG8_BAR; PG8_MMA(0, 0, At, B0); PG8_MMA(0, 1, At, B1); PG8_BAR; PG8_SCHED;
            PG8_LDA(At, 0, 1); PG8_STAGE(PG8_SB(0, 0), b2, voffB); PG8_STAGE(PG8_SB(0, 1), b2 + bstep, voffB); PG8_STAGE(PG8_SA(0, 0), a2, x0);
            PG8_WAIT_V(8); PG8_WAIT_L(0); PG8_BAR; PG8_MMA(1, 0, At, B0); PG8_MMA(1, 1, At, B1); PG8_BAR; PG8_SCHED;
            PG8_LDB(B0, 1, 0); PG8_LDB(B1, 1, 1); PG8_SCHED; PG8_LDA(At, 1, 0); PG8_STAGE(PG8_SA(0, 1), a2, x1);
            PG8_WAIT_V(8); PG8_WAIT_L(0); PG8_BAR; PG8_MMA(0, 0, At, B0); PG8_MMA(0, 1, At, B1); PG8_BAR; PG8_SCHED;
            PG8_LDA(At, 1, 1); PG8_STAGE(PG8_SB(1, 0), b3, voffB); PG8_STAGE(PG8_SB(1, 1), b3 + bstep, voffB); PG8_STAGE(PG8_SA(1, 0), a3, x0);
            PG8_WAIT_V(8); PG8_WAIT_L(0); PG8_BAR; PG8_MMA(1, 0, At, B0); PG8_MMA(1, 1, At, B1); PG8_BAR; PG8_SCHED;
        }
        if (wr == 0) PG8_BAR;
        acc_settle(acc);
        { int l_; asm volatile("v_mbcnt_lo_u32_b32 %0, -1, 0\n\tv_mbcnt_hi_u32_b32 %0, -1, %0" : "=v"(l_)); E(acc, cur, wr, wc, l_ & 15, l_ >> 4); }
        if (!has_next) break;
        asm volatile("; next unit's accumulator init" : "+v"(nb[0][0]), "+v"(nb[0][1]), "+v"(nb[1][0]), "+v"(nb[1][1]), "+v"(env));
#pragma unroll
        for (int a = 0; a < 2; ++a)
#pragma unroll
            for (int b = 0; b < 2; ++b)
#pragma unroll
                for (int m = 0; m < 4; ++m)
#pragma unroll
                    for (int n = 0; n < 2; ++n) { if constexpr (Epi::BIAS) acc[a][b][m][n] = E.bias_xf(nb[b][n], b); else acc[a][b][m][n] = (f32x4){0.f, 0.f, 0.f, 0.f}; }
        cur = nxt; nxt = nx2; has_next = has2; cA = nA; cB = nB; ++ui;
        if constexpr (Prob::EXPERT) { if (has2) nxt.e = __builtin_amdgcn_readfirstlane(env); }
#pragma unroll
        for (int i = 0; i < 2; ++i) { vc0[i] = vn0[i]; vc1[i] = vn1[i]; }
        if (wr == 1) PG8_BAR;
    }
    PG8_WAIT_V(0);
    PG8_BAR;
#undef PG8_SA
#undef PG8_SB
#undef PG8_STAGE
#undef PG8_LDA
#undef PG8_LDB
#undef PG8_MMA
#undef PG8_WAIT_V
#undef PG8_WAIT_L
#undef PG8_BAR
#undef PG8_SCHED
}

struct EpiGLU {
    static constexpr int PERM = 1; static constexpr bool BIAS = true;
    bf16_t* O; const float* bias;
    __device__ __forceinline__ const float* bias_base(const Unit& u, int wc, int bj) const { return bias + bj * 1024 + u.pn * HALF + wc * 32; }
    __device__ __forceinline__ f32x4 bias_xf(f32x4 v, int) const { return v; }
    __device__ __forceinline__ void operator()(const f32x4 (&acc)[2][2][4][2], const Unit& u, int wr, int wc, int fr, int fq) const {
        const int row0 = u.pm * BM + wr * 64 + fr, col0 = u.pn * HALF + wc * 32 + 8 * fq;
#pragma unroll
        for (int ai = 0; ai < 2; ++ai)
#pragma unroll
            for (int m = 0; m < 4; ++m) { bf16_t* rowp = O + (size_t)(row0 + ai * HALF + m * 16) * ZW + col0;
                float o[8];
#pragma unroll
                for (int n = 0; n < 2; ++n) { const f32x4 av = acc[ai][0][m][n], gv = acc[ai][1][m][n];
#pragma unroll
                    for (int j = 0; j < 4; ++j) o[4 * n + j] = av[j] * __builtin_amdgcn_rcpf(1.0f + __builtin_amdgcn_exp2f(gv[j] * -1.4426950408889634f)); }
                u32x4 w; w.x = cvt_pk_bf16(o[0], o[1]); w.y = cvt_pk_bf16(o[2], o[3]); w.z = cvt_pk_bf16(o[4], o[5]); w.w = cvt_pk_bf16(o[6], o[7]);
                *(u32x4*)rowp = w; }
    }
};
struct EpiZ {
    static constexpr int PERM = 1; static constexpr bool BIAS = true;
    bf16_t* O; const float* bias; int zcol0, bcol0, ks0;
    __device__ __forceinline__ const float* bias_base(const Unit& u, int wc, int bj) const { return bias + bcol0 + u.pn * BM + wc * 32 + bj * HALF; }
    __device__ __forceinline__ f32x4 bias_xf(f32x4 v, int) const { return v; }
    __device__ __forceinline__ void operator()(const f32x4 (&acc)[2][2][4][2], const Unit& u, int wr, int wc, int fr, int fq) const {
        const int row0 = u.pm * BM + wr * 64 + fr, col0 = u.pn * BM + wc * 32 + 8 * fq;
        const float sc = (u.pn == ks0 || u.pn == ks0 + 1) ? KSCALE : 1.0f;
#pragma unroll
        for (int ai = 0; ai < 2; ++ai)
#pragma unroll
            for (int m = 0; m < 4; ++m) { bf16_t* rowp = O + (size_t)(row0 + ai * HALF + m * 16) * ZW + zcol0 + col0;
#pragma unroll
                for (int bj = 0; bj < 2; ++bj) { const f32x4 v0 = acc[ai][bj][m][0] * sc, v1 = acc[ai][bj][m][1] * sc;
                    u32x4 w; w.x = cvt_pk_bf16(v0[0], v0[1]); w.y = cvt_pk_bf16(v0[2], v0[3]); w.z = cvt_pk_bf16(v1[0], v1[1]); w.w = cvt_pk_bf16(v1[2], v1[3]);
                    *(u32x4*)(rowp + bj * HALF) = w; } }
    }
};
struct EpiR {
    static constexpr int PERM = 1; static constexpr bool BIAS = false;
    __device__ __forceinline__ const float* bias_base(const Unit&, int, int) const { return nullptr; }
    __device__ __forceinline__ f32x4 bias_xf(f32x4 v, int) const { return v; }
    bf16_t* R; const float* x; const float* mod;
    __device__ __forceinline__ void operator()(const f32x4 (&acc)[2][2][4][2], const Unit& u, int wr, int wc, int fr, int fq) const {
        const int row0 = u.pm * BM + wr * 64 + fr, col0 = u.pn * BM + wc * 32 + 8 * fq;
        const int b = (u.pm * BM) / SEQ;
        f32x4 gv[2][2];
#pragma unroll
        for (int bj = 0; bj < 2; ++bj)
#pragma unroll
            for (int n = 0; n < 2; ++n) gv[bj][n] = *(const f32x4*)(mod + (size_t)b * 12288 + 4096 + col0 + bj * HALF + 4 * n);
#pragma unroll
        for (int ai = 0; ai < 2; ++ai)
#pragma unroll
            for (int m = 0; m < 4; ++m) { const size_t off = (size_t)(row0 + ai * HALF + m * 16) * D + col0;
#pragma unroll
                for (int bj = 0; bj < 2; ++bj) { const f32x4 x0 = *(const f32x4*)(x + off + bj * HALF), x1v = *(const f32x4*)(x + off + bj * HALF + 4);
                    const f32x4 v0 = x0 * ALPHA + gv[bj][0] * acc[ai][bj][m][0], v1 = x1v * ALPHA + gv[bj][1] * acc[ai][bj][m][1];
                    u32x4 w; w.x = cvt_pk_bf16(v0[0], v0[1]); w.y = cvt_pk_bf16(v0[2], v0[3]); w.z = cvt_pk_bf16(v1[0], v1[1]); w.w = cvt_pk_bf16(v1[2], v1[3]);
                    *(u32x4*)(R + off + bj * HALF) = w; }
                asm volatile("" ::: "memory"); }
    }
};
struct EpiAct {
    static constexpr int PERM = 1; static constexpr bool BIAS = true;
    unsigned char* O; const float* bg; const float* bu; const int* tile_e;
    __device__ __forceinline__ const float* bias_base(const Unit& u, int wc, int bj) const { return (bj ? bu : bg) + (size_t)u.e * D + u.pn * HALF + wc * 32; }
    __device__ __forceinline__ f32x4 bias_xf(f32x4 v, int bj) const { return bj ? v + 1.0f : v; }
    __device__ __forceinline__ void operator()(const f32x4 (&acc)[2][2][4][2], const Unit& u, int wr, int wc, int fr, int fq) const {
        const int row0 = u.pm * BM + wr * 64 + fr;
        const int colw = u.pn * HALF + wc * 32 + 16 * (fq >> 1), rsel = fq & 1;
#pragma unroll
        for (int ai = 0; ai < 2; ++ai)
#pragma unroll
            for (int mp = 0; mp < 2; ++mp) {
                u32x2 w2[2];
#pragma unroll
                for (int h = 0; h < 2; ++h) { const int m = 2 * mp + h; float o[8];
#pragma unroll
                    for (int n = 0; n < 2; ++n) { const f32x4 gt = acc[ai][0][m][n], up = acc[ai][1][m][n];
#pragma unroll
                        for (int j = 0; j < 4; ++j) {
                            const float a = fminf(gt[j], 7.0f), u1 = fminf(fmaxf(up[j], -6.0f), 8.0f);
                            o[4 * n + j] = a * u1 * __builtin_amdgcn_rcpf(__builtin_fmaf(__builtin_amdgcn_exp2f(a * -2.4554669595930156f), 0.25f, 0.25f)); } }
                    w2[h].x = cvt4_fp8(o[0], o[1], o[2], o[3]); w2[h].y = cvt4_fp8(o[4], o[5], o[6], o[7]); }
                const auto rx = __builtin_amdgcn_permlane16_swap(w2[0].x, w2[1].x, false, false), ry = __builtin_amdgcn_permlane16_swap(w2[0].y, w2[1].y, false, false);
                *(u32x4*)(O + (size_t)(row0 + ai * HALF + (2 * mp + rsel) * 16) * D + colw) = (u32x4){rx[0], ry[0], rx[1], ry[1]}; }
    }
};
struct EpiY {
    static constexpr int PERM = 2; static constexpr bool BIAS = true;
    unsigned char* O; const float* bias; const int* tile_e;
    __device__ __forceinline__ const float* bias_base(const Unit& u, int wc, int bj) const { return bias + (size_t)u.e * D + u.pn * BM + wc * 64 + bj * 32; }
    __device__ __forceinline__ f32x4 bias_xf(f32x4 v, int) const { return v * 8.0f; }
    __device__ __forceinline__ void operator()(const f32x4 (&acc)[2][2][4][2], const Unit& u, int wr, int wc, int fr, int fq) const {
        const int row0 = u.pm * BM + wr * 64 + fr;
        const int colw = u.pn * BM + wc * 64 + ((fq & 1) ? 32 + 8 * (fq - 1) : 8 * fq);
#pragma unroll
        for (int ai = 0; ai < 2; ++ai)
#pragma unroll
            for (int m = 0; m < 4; ++m) {
                u32x2 w2[2];
#pragma unroll
                for (int bj = 0; bj < 2; ++bj) { const f32x4 v0 = acc[ai][bj][m][0], v1 = acc[ai][bj][m][1];
                    w2[bj].x = cvt4_fp8(v0[0], v0[1], v0[2], v0[3]); w2[bj].y = cvt4_fp8(v1[0], v1[1], v1[2], v1[3]); }
                const auto rx = __builtin_amdgcn_permlane16_swap(w2[0].x, w2[1].x, false, false), ry = __builtin_amdgcn_permlane16_swap(w2[0].y, w2[1].y, false, false);
                *(u32x4*)(O + (size_t)(row0 + ai * HALF + m * 16) * D + colw) = (u32x4){rx[0], ry[0], rx[1], ry[1]}; }
    }
};
}

#define XB_TMO      128
#define XB_XCNT(j)  (256  + 64 * (j))
#define XB_XSUB(j)  (1280 + 64 * (j))
#define XB_XGEN(j)  (2304 + 64 * (j))
#define XB_TOP      3328
#define XB_TOPGEN   3392
#define XCD_BAR_WORDS 3456
#define XB_SPIN_CAP (1u << 18)
__device__ __forceinline__ unsigned xb_ld(unsigned* p)              { return __hip_atomic_load(p, __ATOMIC_RELAXED, __HIP_MEMORY_SCOPE_AGENT); }
__device__ __forceinline__ unsigned xb_add(unsigned* p, unsigned v) { return __hip_atomic_fetch_add(p, v, __ATOMIC_RELAXED, __HIP_MEMORY_SCOPE_AGENT); }
__device__ __forceinline__ unsigned xb_xcc_id() { return (unsigned)__builtin_amdgcn_s_getreg((3 << 11) | 20) & 0xFu; }
#define XB_SPIN(cond, bar) do { unsigned _sp = 0; while (cond) { __builtin_amdgcn_s_sleep(1); \
    if ((++_sp & 255u) == 0u) { if (xb_ld(&(bar)[XB_TMO])) break; if (_sp > XB_SPIN_CAP) { atomicAdd(&(bar)[XB_TMO], 1u); break; } } } } while (0)
struct XcdBarrier { unsigned* bar; unsigned x; volatile LAS unsigned* st; };
__device__ __forceinline__ XcdBarrier xcd_barrier_post(unsigned* bar, volatile LAS unsigned* st, int tid) {
    XcdBarrier b; b.bar = bar; b.x = xb_xcc_id(); b.st = st;
    if (tid == 0) (void)xb_add(&bar[XB_XCNT(b.x)], 1u);
    return b;
}
__device__ __forceinline__ void xcd_barrier_complete(unsigned* bar, unsigned x, unsigned& nloc, unsigned& nx) {
    const unsigned G = gridDim.x * gridDim.y * gridDim.z;
    unsigned sum, cnt, mine, sp = 0u;
    for (;;) {
        sum = 0u; cnt = 0u; mine = 0u;
#pragma unroll
        for (unsigned j = 0; j < 16; ++j) { const unsigned c = xb_ld(&bar[XB_XCNT(j)]); sum += c; cnt += (c > 0u) ? 1u : 0u; mine = (j == x) ? c : mine; }
        if (sum == G) break;
        __builtin_amdgcn_s_sleep(1);
        if ((++sp & 255u) == 0u) { if (xb_ld(&bar[XB_TMO])) break; if (sp > XB_SPIN_CAP) { atomicAdd(&bar[XB_TMO], 1u); break; } }
    }
    nloc = mine > 0u ? mine : 1u; nx = cnt > 0u ? cnt : 1u;
}
__device__ __forceinline__ void xcd_barrier(const XcdBarrier& b, int tid) {
    asm volatile("s_waitcnt vmcnt(0)" ::: "memory");
    __syncthreads();
    if (tid == 0) {
        unsigned* bar = b.bar;
        __builtin_amdgcn_s_waitcnt(0);
        unsigned nloc = b.st[0], nx = b.st[1];
        if (nloc == 0u) { xcd_barrier_complete(bar, b.x, nloc, nx); b.st[0] = nloc; b.st[1] = nx; }
        const unsigned old = xb_add(&bar[XB_XSUB(b.x)], 1u);
        const unsigned gen = old / nloc;
        if (old + 1u == (gen + 1u) * nloc) {
            __builtin_amdgcn_fence(__ATOMIC_RELEASE, "agent");
            asm volatile("s_waitcnt vmcnt(0)" ::: "memory");
            const unsigned og = xb_add(&bar[XB_TOP], 1u);
            const unsigned tg = og / nx;
            if (og + 1u == (tg + 1u) * nx) xb_add(&bar[XB_TOPGEN], 1u);
            else XB_SPIN(xb_ld(&bar[XB_TOPGEN]) == tg, bar);
            __builtin_amdgcn_fence(__ATOMIC_ACQUIRE, "agent");
            xb_add(&bar[XB_XGEN(b.x)], 1u);
            asm volatile("s_waitcnt vmcnt(0)" ::: "memory");
        } else {
            XB_SPIN(xb_ld(&bar[XB_XGEN(b.x)]) == gen, bar);
            __builtin_amdgcn_fence(__ATOMIC_ACQUIRE, "agent");
            asm volatile("s_waitcnt vmcnt(0)" ::: "memory");
        }
    }
    __syncthreads();
}

struct Args { const float* in[24]; float* out; unsigned char* ws; int ph_lo, ph_hi; };
enum { I_X = 0, I_C, I_WADA, I_BADA, I_WIN, I_BIN, I_DWW, I_DWB, I_CLG, I_CLB, I_MHG, I_WOUT, I_LN1G, I_LN1B, I_RW, I_RB, I_WG, I_BG, I_WU, I_BU, I_WD, I_BD, I_LN2G, I_LN2B };

__device__ __forceinline__ void tr_item(const float* __restrict__ src, int ld, int k0, int n0, bf16_t* dst, size_t drow0, int lane) {
    float v[64];
    const float* sp = src + (size_t)k0 * ld + n0 + lane;
#pragma unroll
    for (int i = 0; i < 64; ++i) v[i] = sp[(size_t)i * ld];
    u32x4* dp = (u32x4*)(dst + (drow0 + lane) * 2048 + k0);
#pragma unroll
    for (int c = 0; c < 8; ++c) { u32x4 o; o.x = cvt_pk_bf16(v[8 * c], v[8 * c + 1]); o.y = cvt_pk_bf16(v[8 * c + 2], v[8 * c + 3]); o.z = cvt_pk_bf16(v[8 * c + 4], v[8 * c + 5]); o.w = cvt_pk_bf16(v[8 * c + 6], v[8 * c + 7]); dp[c] = o; }
}
__device__ __forceinline__ void tr_item8(const float* __restrict__ src, int ld, int k0, int n0, unsigned char* dst, size_t drow0, int lane) {
    float v[64];
    const float* sp = src + (size_t)k0 * ld + n0 + lane;
#pragma unroll
    for (int i = 0; i < 64; ++i) v[i] = sp[(size_t)i * ld] * 64.0f;
    u32x4* dp = (u32x4*)(dst + (drow0 + lane) * 2048 + k0);
#pragma unroll
    for (int c = 0; c < 4; ++c) { u32x4 o; o.x = cvt4_fp8(v[16 * c], v[16 * c + 1], v[16 * c + 2], v[16 * c + 3]); o.y = cvt4_fp8(v[16 * c + 4], v[16 * c + 5], v[16 * c + 6], v[16 * c + 7]);
        o.z = cvt4_fp8(v[16 * c + 8], v[16 * c + 9], v[16 * c + 10], v[16 * c + 11]); o.w = cvt4_fp8(v[16 * c + 12], v[16 * c + 13], v[16 * c + 14], v[16 * c + 15]); dp[c] = o; }
}
__device__ __forceinline__ void phase0(const Args& a, LAS unsigned char* lds, int bid, int G, int tid) {
    const int lane = tid & 63, wave = __builtin_amdgcn_readfirstlane(tid >> 6);
    {
        constexpr int T_IN = 16 * 40, T_SQ = 16 * 16, NTILE = T_IN + T_SQ + 96 * T_SQ;
        const int jq = tid & 7, n_a = tid >> 3;
#define P0_DECODE(t_, src_, ld_, k0_, n0_, kind_, e_) do { int r_ = (t_); \
            if (r_ < T_IN) { n0_ = (r_ % 40) * 128; k0_ = (r_ / 40) * 128; src_ = a.in[I_WIN]; ld_ = DIN; kind_ = 0; e_ = 0; } \
            else { r_ -= T_IN; int mtx_ = 0; if (r_ >= T_SQ) { r_ -= T_SQ; mtx_ = 1 + r_ / T_SQ; r_ = r_ % T_SQ; } \
                n0_ = (r_ & 15) * 128; k0_ = (r_ >> 4) * 128; ld_ = D; \
                if (mtx_ == 0) { src_ = a.in[I_WOUT]; kind_ = 1; e_ = 0; } else { const int m3 = (mtx_ - 1) % 3; e_ = (mtx_ - 1) / 3; kind_ = 2 + m3; \
                    src_ = a.in[m3 == 0 ? I_WG : m3 == 1 ? I_WU : I_WD] + (size_t)e_ * D * D; } } } while (0)
#define P0_ISSUE(t_, buf_) do { const float* src_; int ld_, k0_, n0_, kind_, e_; P0_DECODE(t_, src_, ld_, k0_, n0_, kind_, e_); (void)kind_; (void)e_; \
            _Pragma("unroll") for (int r_ = 0; r_ < 8; ++r_) __builtin_amdgcn_global_load_lds((const unsigned*)(src_ + (size_t)(k0_ + wave * 16 + 2 * r_ + (lane >> 5)) * ld_ + n0_ + 4 * (((lane & 31) + 2 * wave) & 31)), \
                (LAS unsigned*)(lds + (buf_) * 65536 + (wave * 16 + 2 * r_) * 512), 16, 0, 0); } while (0)
        int t = bid, it = 0;
        if (t < NTILE) P0_ISSUE(t, 0);
        for (; t < NTILE; t += G, ++it) {
            const int tn = t + G, cb = it & 1;
            if (tn < NTILE) { P0_ISSUE(tn, cb ^ 1); asm volatile("s_waitcnt vmcnt(8)" ::: "memory"); }
            else asm volatile("s_waitcnt vmcnt(0)" ::: "memory");
            __builtin_amdgcn_s_barrier();
            const float* src; int ld, k0, n0, kind, e; P0_DECODE(t, src, ld, k0, n0, kind, e); (void)src; (void)ld;
            float v[32];
#pragma unroll
            for (int h = 0; h < 2; ++h) { const int n = n_a + 64 * h;
                const LAS float* col = (const LAS float*)(lds + cb * 65536) + (16 * jq) * 128 + 4 * (((n >> 2) - 2 * jq) & 31) + (n & 3);
#pragma unroll
                for (int i = 0; i < 16; ++i) v[16 * h + i] = col[i * 128]; }
#pragma unroll
            for (int h = 0; h < 2; ++h) { const int n = n0 + n_a + 64 * h;
                unsigned char* base; size_t dr;
                if (kind == 0) { base = a.ws + WS_WTIN; dr = n < 1024 ? (size_t)(n >> 7) * 256 + (n & 127) : n < 2048 ? (size_t)((n - 1024) >> 7) * 256 + 128 + (n & 127) : (size_t)n; }
                else if (kind == 1) { base = a.ws + WS_WTOUT; dr = (size_t)n; }
                else if (kind == 4) { base = a.ws + WS_WTDN; dr = (size_t)e * 2048 + n; }
                else { base = a.ws + WS_WTGU; dr = (size_t)e * 4096 + (size_t)(n >> 7) * 256 + (n & 127) + (kind == 3 ? 128 : 0); }
                u32x4 o; const int c = h;
                o.x = cvt4_fp8(v[16 * c] * 64.f, v[16 * c + 1] * 64.f, v[16 * c + 2] * 64.f, v[16 * c + 3] * 64.f); o.y = cvt4_fp8(v[16 * c + 4] * 64.f, v[16 * c + 5] * 64.f, v[16 * c + 6] * 64.f, v[16 * c + 7] * 64.f);
                o.z = cvt4_fp8(v[16 * c + 8] * 64.f, v[16 * c + 9] * 64.f, v[16 * c + 10] * 64.f, v[16 * c + 11] * 64.f); o.w = cvt4_fp8(v[16 * c + 12] * 64.f, v[16 * c + 13] * 64.f, v[16 * c + 14] * 64.f, v[16 * c + 15] * 64.f);
                *(u32x4*)(base + dr * 2048 + k0 + 16 * jq) = o; }
            asm volatile("s_waitcnt lgkmcnt(0)" ::: "memory");
            __builtin_amdgcn_s_barrier();
        }
        asm volatile("s_waitcnt vmcnt(0)" ::: "memory");
        __syncthreads();
#undef P0_DECODE
#undef P0_ISSUE
    }
    LAS float* s_c = (LAS float*)lds;
    LAS float* s_red = s_c + 2048 * 8;
    float* mod = (float*)(a.ws + WS_MOD);
    for (int it = bid; it < 256; it += G) {
        __syncthreads();
        for (int i = tid; i < 8 * 2048; i += 512) { const int b = i >> 11, k = i & 2047; const float v = a.in[I_C][i]; s_c[k * 8 + b] = v * sigmoidf_(v); }
        __syncthreads();
        const int c4 = lane % 12, kq = lane / 12;
        f32x4 acc[8];
#pragma unroll
        for (int b = 0; b < 8; ++b) acc[b] = (f32x4){0.f, 0.f, 0.f, 0.f};
        if (kq < 5) {
            const float* wp = a.in[I_WADA] + (size_t)(wave * 256) * 12288 + it * 48 + 4 * c4;
            for (int i0 = 0; i0 < 52; i0 += 13) {
                f32x4 w4[13];
#pragma unroll
                for (int u = 0; u < 13; ++u) { const int k = kq + 5 * (i0 + u), kc = k < 256 ? k : 255; w4[u] = *(const f32x4*)(wp + (size_t)kc * 12288); }
                asm volatile("" ::: "memory");
#pragma unroll
                for (int u = 0; u < 13; ++u) { const int k = kq + 5 * (i0 + u), kc = k < 256 ? k : 255; const float m = k < 256 ? 1.0f : 0.0f;
                    const f32x4 s0 = *(const LAS f32x4*)(s_c + (wave * 256 + kc) * 8) * m, s1 = *(const LAS f32x4*)(s_c + (wave * 256 + kc) * 8 + 4) * m;
                    acc[0] += w4[u] * s0[0]; acc[1] += w4[u] * s0[1]; acc[2] += w4[u] * s0[2]; acc[3] += w4[u] * s0[3];
                    acc[4] += w4[u] * s1[0]; acc[5] += w4[u] * s1[1]; acc[6] += w4[u] * s1[2]; acc[7] += w4[u] * s1[3]; }
            }
#pragma unroll
            for (int b = 0; b < 8; ++b) *(LAS f32x4*)(s_red + ((wave * 5 + kq) * 8 + b) * 48 + 4 * c4) = acc[b];
        }
        __syncthreads();
        if (tid < 384) { const int b = tid / 48, cc = tid % 48; float s = 0.f;
#pragma unroll 8
            for (int w = 0; w < 40; ++w) s += s_red[(w * 8 + b) * 48 + cc];
            mod[b * 12288 + it * 48 + cc] = s + a.in[I_BADA][it * 48 + cc]; }
    }
    if (bid < 16) {
        const int it = bid * 512 + tid, ln = it & 63, f = it >> 6, h = f & 1, ks = (f >> 1) & 3, c = (f >> 3) & 1, wv_ = f >> 4;
        float wv[8];
#pragma unroll
        for (int j = 0; j < 8; ++j) wv[j] = a.in[I_RW][(size_t)(1024 * c + 128 * wv_ + 32 * ks + 8 * (ln >> 4) + j) * 32 + 16 * h + (ln & 15)];
        u32x4 hi_, lo_;
#pragma unroll
        for (int q = 0; q < 4; ++q) { const unsigned hp = cvt_pk_bf16(wv[2 * q], wv[2 * q + 1]); hi_[q] = hp; lo_[q] = cvt_pk_bf16(wv[2 * q] - bf_lo(hp), wv[2 * q + 1] - bf_hi(hp)); }
        u32x4* tb = (u32x4*)(a.ws + WS_WRT) + ((size_t)f * 2) * 64 + ln; tb[0] = hi_; tb[64] = lo_;
    } else if (bid < 24) {
        const int it = (bid - 16) * 512 + tid, ln = it & 63, f = it >> 6, ks = f & 3, c = (f >> 2) & 1, wv_ = f >> 3;
        float wv[8];
#pragma unroll
        for (int j = 0; j < 8; ++j) wv[j] = (ln & 8) ? 0.f : a.in[I_WIN][(size_t)(1024 * c + 128 * wv_ + 32 * ks + 8 * (ln >> 4) + j) * DIN + DINP + (ln & 7)];
        u32x4 hi_, lo_;
#pragma unroll
        for (int q = 0; q < 4; ++q) { const unsigned hp = cvt_pk_bf16(wv[2 * q], wv[2 * q + 1]); hi_[q] = hp; lo_[q] = cvt_pk_bf16(wv[2 * q] - bf_lo(hp), wv[2 * q + 1] - bf_hi(hp)); }
        u32x4* tb = (u32x4*)(a.ws + WS_WRT + 524288) + ((size_t)f * 2) * 64 + ln; tb[0] = hi_; tb[64] = lo_;
    }
}

constexpr int PT_STR = 1032, PT_LO = 16 * PT_STR * 2;
__device__ __forceinline__ void pt_put(LAS unsigned char* tile, int row, int ch, f32x4 v) {
    const unsigned h0 = cvt_pk_bf16(v[0], v[1]), h1 = cvt_pk_bf16(v[2], v[3]);
    const unsigned l0 = cvt_pk_bf16(v[0] - bf_lo(h0), v[1] - bf_hi(h0)), l1 = cvt_pk_bf16(v[2] - bf_lo(h1), v[3] - bf_hi(h1));
    *(LAS u32x2*)(tile + row * (PT_STR * 2) + ch * 2) = (u32x2){h0, h1}; *(LAS u32x2*)(tile + PT_LO + row * (PT_STR * 2) + ch * 2) = (u32x2){l0, l1};
}
#define MFMA16(a, b, c) __builtin_amdgcn_mfma_f32_16x16x32_bf16((a), (b), (c), 0, 0, 0)
__device__ __forceinline__ void phase1(const Args& a, LAS unsigned char* lds, int bid, int G, int tid) {
    const int lane = tid & 63, wave = tid >> 6;
    LAS float* s_sc = (LAS float*)lds; LAS float* s_sh = s_sc + 2048; LAS unsigned char* tile = lds + 16384; LAS float* red = (LAS float*)(lds + 16384 + 2 * PT_LO);
    const float* mod = (const float*)(a.ws + WS_MOD); float* gates = (float*)(a.ws + WS_GATES); unsigned char* h8 = a.ws + WS_HF8;
    const float* x = a.in[I_X];
    float ghi[2][4][4], glo[2][4][4];
    { const u32x4* tb = (const u32x4*)(a.ws + WS_WRT + 524288) + (size_t)(wave * 8) * 2 * 64 + lane;
#pragma unroll
      for (int c = 0; c < 2; ++c)
#pragma unroll
          for (int ks = 0; ks < 4; ++ks) { const int f = c * 4 + ks; const u32x4 hv_ = tb[(f * 2) * 64], lv_ = tb[(f * 2 + 1) * 64];
#pragma unroll
              for (int q = 0; q < 4; ++q) { asm volatile("v_accvgpr_write_b32 %0, %1" : "=a"(ghi[c][ks][q]) : "v"(hv_[q])); asm volatile("v_accvgpr_write_b32 %0, %1" : "=a"(glo[c][ks][q]) : "v"(lv_[q])); } } }
    for (int p = bid; p < T / 128; p += G) {
        const int b = (p * 128) / SEQ;
        __syncthreads();
        { int l_; asm volatile("v_mbcnt_lo_u32_b32 %0, -1, 0\n\tv_mbcnt_hi_u32_b32 %0, -1, %0" : "=v"(l_)); const int t0 = __builtin_amdgcn_readfirstlane(wave) * 64 + l_;
          for (int i = t0; i < 2048; i += 512) { s_sh[i] = mod[b * 12288 + i]; s_sc[i] = 1.0f + mod[b * 12288 + 2048 + i]; } }
        __syncthreads();
        f32x4 nx[8];
        { const f32x4* xr = (const f32x4*)(x + (size_t)(p * 128 + 2 * wave) * D) + lane;
#pragma unroll
          for (int j = 0; j < 8; ++j) nx[j] = xr[64 * j]; }
        for (int tl = 0; tl < 8; ++tl) {
            f32x4 hc1[2][4];
#pragma unroll
            for (int rr = 0; rr < 2; ++rr) {
                const int row = p * 128 + tl * 16 + 2 * wave + rr;
                f32x4 v[8]; float s = 0.f;
#pragma unroll
                for (int j = 0; j < 8; ++j) { v[j] = nx[j]; s += (v[j][0] + v[j][1]) + (v[j][2] + v[j][3]); }
                { const int rn = rr == 0 ? row + 1 : (tl < 7 ? row + 15 : row); const f32x4* xr = (const f32x4*)(x + (size_t)rn * D) + lane;
#pragma unroll
                  for (int j = 0; j < 8; ++j) nx[j] = xr[64 * j]; }
                const float mean = wave_sum(s) * (1.0f / D); float s2 = 0.f;
#pragma unroll
                for (int j = 0; j < 8; ++j) { v[j] = v[j] - mean; s2 += (v[j][0] * v[j][0] + v[j][1] * v[j][1]) + (v[j][2] * v[j][2] + v[j][3] * v[j][3]); }
                const float rstd = 1.0f / sqrtf(wave_sum(s2) * (1.0f / D) + LN_EPS);
                unsigned* o4 = (unsigned*)(h8 + (size_t)row * D) + lane;
#pragma unroll
                for (int j = 0; j < 8; ++j) { const f32x4 sc = *(const LAS f32x4*)(s_sc + 4 * lane + 256 * j), sh = *(const LAS f32x4*)(s_sh + 4 * lane + 256 * j);
                    const f32x4 hv = v[j] * rstd * sc + sh; o4[64 * j] = cvt4_fp8(hv[0], hv[1], hv[2], hv[3]);
                    if (j < 4) pt_put(tile, 2 * wave + rr, 4 * lane + 256 * j, hv); else hc1[rr][j - 4] = hv; }
                asm volatile("" ::: "memory");
            }
            f32x4 acc = (f32x4){0.f, 0.f, 0.f, 0.f};
#pragma unroll
            for (int c = 0; c < 2; ++c) {
                if (c == 1) {
                    __syncthreads();
#pragma unroll
                    for (int rr = 0; rr < 2; ++rr)
#pragma unroll
                        for (int jj = 0; jj < 4; ++jj) pt_put(tile, 2 * wave + rr, 4 * lane + 256 * jj, hc1[rr][jj]);
                }
                __syncthreads();
                const LAS unsigned char* ap = tile + (lane & 15) * (PT_STR * 2) + (128 * wave + 8 * (lane >> 4)) * 2;
#pragma unroll
                for (int ks = 0; ks < 4; ++ks) { const bf16x8 ah = *(const LAS bf16x8*)(ap + 64 * ks), al = *(const LAS bf16x8*)(ap + PT_LO + 64 * ks);
#pragma unroll
                    for (int q = 0; q < 4; ++q) asm volatile("" : "+a"(ghi[c][ks][q]), "+a"(glo[c][ks][q]));
                    const bf16x8 bh = __builtin_bit_cast(bf16x8, (f32x4){ghi[c][ks][0], ghi[c][ks][1], ghi[c][ks][2], ghi[c][ks][3]});
                    const bf16x8 bl = __builtin_bit_cast(bf16x8, (f32x4){glo[c][ks][0], glo[c][ks][1], glo[c][ks][2], glo[c][ks][3]});
                    acc = MFMA16(ah, bh, acc); acc = MFMA16(ah, bl, acc); acc = MFMA16(al, bh, acc); }
            }
#pragma unroll
            for (int q = 0; q < 4; ++q) red[(wave * 16 + 4 * (lane >> 4) + q) * 16 + (lane & 15)] = acc[q];
            __syncthreads();
            if (tid < 128) { const int rw_ = tid >> 3, gq = tid & 7; float g = a.in[I_BIN][DINP + gq];
#pragma unroll
                for (int w = 0; w < 8; ++w) g += red[(w * 16 + rw_) * 16 + gq];
                gates[(size_t)(p * 128 + tl * 16 + rw_) * 8 + gq] = g; }
        }
    }
}

constexpr int ML_QK = 32768, ML_K = 16384;
constexpr int ML_VR = 3 * ML_QK, ML_SCS = ML_VR + 3 * 4096;
constexpr int ML_CT = ML_SCS + 3 * 2048;
__device__ __forceinline__ unsigned off_b(unsigned row, unsigned ch) { return 256u * row + 16u * (ch ^ (((row & 3u) << 2) | ((row >> 2) & 3u))); }
__device__ __forceinline__ s16x4 vtr(const LAS unsigned char* p) { return __builtin_bit_cast(s16x4, __builtin_amdgcn_ds_read_tr16_b64_v4i16((LAS v4i16_t*)p)); }
__device__ __forceinline__ bf16x8 cat8(s16x4 lo, s16x4 hi) { return __builtin_shufflevector(lo, hi, 0, 1, 2, 3, 4, 5, 6, 7); }
__device__ __forceinline__ float scan_add(float v, int lane) {
#pragma unroll
    for (int d = 1; d < 64; d <<= 1) { const float t = __shfl_up(v, d); v = (lane >= d) ? v + t : v; }
    return v;
}
__device__ __forceinline__ float scan_max(float v, int lane) {
#pragma unroll
    for (int d = 1; d < 64; d <<= 1) { const float t = __shfl_up(v, d); v = (lane >= d) ? fmaxf(v, t) : v; }
    return v;
}

__device__ __forceinline__ void mlstm_chain(const Args& a, LAS unsigned char* lds, int chain, int slice, int tid) {
    const int lane = tid & 63, wave = __builtin_amdgcn_readfirstlane(tid >> 6);
    const int b = chain >> 2, hd = chain & 3;
    const bf16_t* z = (const bf16_t*)(a.ws + WS_Z); const float* gates = (const float*)(a.ws + WS_GATES); bf16_t* hbuf = (bf16_t*)(a.ws + WS_HBUF);
    const size_t tb = (size_t)b * SEQ;
    const int qcol = 1024 + hd * 128, kcol = 1536 + hd * 128, vcol = 2048 + hd * 256 + slice * 32;
    const int l_loc = lane & 15, g = lane >> 4, q4 = l_loc >> 2, p4 = l_loc & 3;
    const unsigned ldsbase = (unsigned)(__UINTPTR_TYPE__)lds;
    float* scal = (float*)(a.ws + WS_SCAL) + (size_t)(chain * 8 + slice) * (64 * 384);
    f32x4 st[2][3];
#pragma unroll
    for (int i = 0; i < 2; ++i)
#pragma unroll
        for (int c = 0; c < 3; ++c) st[i][c] = (f32x4){0.f, 0.f, 0.f, 0.f};

    {
        LAS float* pA = (LAS float*)(lds + 65536); LAS float* pB = pA + 4096; LAS float* pM = pB + 4096; LAS float* pC = pM + 4096;
        float giA[8], gfA[8];
#pragma unroll
        for (int j = 0; j < 8; ++j) { const size_t t0_ = tb + (size_t)(wave + 8 * j) * 64; giA[j] = gates[(t0_ + lane) * 8 + hd]; gfA[j] = gates[(t0_ + lane) * 8 + 4 + hd]; }
        asm volatile("" ::: "memory");
#pragma unroll
        for (int j = 0; j < 8; ++j) { const int c = wave + 8 * j;
            const float gi_ = giA[j], gf_ = gfA[j];
            const float lf_ = fminf(gf_, 0.f) - log1pf(__expf(-fabsf(gf_)));
            const float bb_ = scan_add(lf_, lane), aa_ = gi_ - bb_, am_ = scan_max(aa_, lane);
            pA[c * 64 + lane] = aa_; pB[c * 64 + lane] = bb_; pM[c * 64 + lane] = am_;
            if (lane == 63) { pC[c] = bb_; pC[64 + c] = am_; }
        }
        __syncthreads();
        if (wave == 0) {
            float p_ = pC[lane], q_ = pC[64 + lane] + p_;
#pragma unroll
            for (int d = 1; d < 64; d <<= 1) { const float pp = __shfl_up(p_, d), qp = __shfl_up(q_, d); if (lane >= d) { q_ = fmaxf(qp + p_, q_); p_ = pp + p_; } }
            const float m_after = fmaxf(p_, q_);
            float m_in_ = __shfl_up(m_after, 1); if (lane == 0) m_in_ = 0.f;
            pC[128 + lane] = m_in_; pC[192 + lane] = fmaxf(m_in_, pC[64 + lane]);
        }
        __syncthreads();
        for (int c = wave; c < 64; c += 8) {
            const float aa_ = pA[c * 64 + lane], bb_ = pB[c * 64 + lane], am_ = pM[c * 64 + lane], m_in_ = pC[128 + c], mxa_ = pC[192 + c];
            const float mx_ = fmaxf(m_in_, am_);
            float* o_ = scal + (size_t)c * 384;
            o_[lane] = aa_; o_[64 + lane] = -mx_; o_[128 + lane] = __expf(m_in_ - mx_); o_[192 + lane] = __expf(-(bb_ + mx_)); o_[256 + lane] = __expf(aa_ - mxa_);
            if (lane == 0) o_[320] = __expf(m_in_ - mxa_);
        }
        asm volatile("s_waitcnt vmcnt(0)" ::: "memory");
        __syncthreads();
    }
#define ML_DMA(ldsaddr_, gptr_) asm volatile("s_mov_b32 m0, %0\n\ts_nop 0\n\tglobal_load_lds_dwordx4 %1, off" :: "s"(ldsaddr_), "v"(gptr_) : "memory")
#define ML_ISSUE(c_, cb_) do { const size_t t0_ = tb + (size_t)(c_) * 64; const unsigned cbu_ = (unsigned)__builtin_amdgcn_readfirstlane(cb_); const unsigned qb_ = ldsbase + cbu_ * (unsigned)ML_QK; \
        _Pragma("unroll") for (int i_ = 0; i_ < 2; ++i_) { const int r_ = 4 * (i_ * 8 + wave) + (lane >> 4), ch_ = (lane & 15) ^ (((r_ & 3) << 2) | ((r_ >> 2) & 3)); \
            const bf16_t* gq_ = z + (t0_ + r_) * ZW + qcol + 8 * ch_; const bf16_t* gk_ = z + (t0_ + r_) * ZW + kcol + 8 * ch_; \
            ML_DMA(qb_ + (unsigned)(i_ * 8 + wave) * 1024u, gq_); ML_DMA(qb_ + (unsigned)ML_K + (unsigned)(i_ * 8 + wave) * 1024u, gk_); } \
        if (wave < 4) { const bf16_t* gv_ = z + (t0_ + (tid >> 2)) * ZW + vcol + 8 * (tid & 3); ML_DMA(ldsbase + (unsigned)ML_VR + cbu_ * 4096u + (unsigned)wave * 1024u, gv_); } \
        else if (wave == 4) { const float* gs_ = scal + (size_t)(c_) * 384 + 4 * lane; ML_DMA(ldsbase + (unsigned)ML_SCS + cbu_ * 2048u, gs_); } \
        else if (wave == 5) { if (lane < 32) { const float* gs_ = scal + (size_t)(c_) * 384 + 256 + 4 * lane; ML_DMA(ldsbase + (unsigned)ML_SCS + cbu_ * 2048u + 1024u, gs_); } } } while (0)

    for (int i = tid; i < 12288 / 16; i += 512) *(LAS u32x4*)(lds + ML_CT + 16 * i) = (u32x4){0u, 0u, 0u, 0u};
    ML_ISSUE(0, 0); ML_ISSUE(1, 1);
    if (wave < 6) asm volatile("s_waitcnt vmcnt(5)" ::: "memory"); else asm volatile("s_waitcnt vmcnt(4)" ::: "memory");
    __syncthreads();
    int cb = 0;
    for (int c = 0; c < 64; ++c) {
        const int bsel = c & 1;
        const LAS unsigned char* BQ = lds + cb * ML_QK;
        const LAS unsigned char* BV = lds + ML_VR + cb * 4096;
        const LAS float* sc = (const LAS float*)(lds + ML_SCS + cb * 2048);
        const LAS unsigned char* ctc = lds + ML_CT + bsel * 12288;
        LAS unsigned char* ctn = lds + ML_CT + (bsel ^ 1) * 12288;
        { const int cb2 = cb == 0 ? 2 : cb - 1; if (c + 2 < 64) ML_ISSUE(c + 2, cb2); }
        if (wave < 4) {
            const int mt = wave, l = 16 * mt + l_loc;
            bf16x8 qf[4];
#pragma unroll
            for (int ks = 0; ks < 4; ++ks) qf[ks] = *(const LAS bf16x8*)(BQ + off_b(l, 4 * ks + g));
            f32x4 aS[4];
#pragma unroll
            for (int np = 0; np < 2; ++np) { bf16x8 kf[2][4];
#pragma unroll
                for (int h = 0; h < 2; ++h)
#pragma unroll
                    for (int ks = 0; ks < 4; ++ks) kf[h][ks] = *(const LAS bf16x8*)(BQ + ML_K + off_b(16 * (2 * np + h) + l_loc, 4 * ks + g));
                asm volatile("" ::: "memory");
                aS[2 * np] = (f32x4){0.f, 0.f, 0.f, 0.f}; aS[2 * np + 1] = (f32x4){0.f, 0.f, 0.f, 0.f};
#pragma unroll
                for (int ks = 0; ks < 4; ++ks) { aS[2 * np] = MFMA16(kf[0][ks], qf[ks], aS[2 * np]); aS[2 * np + 1] = MFMA16(kf[1][ks], qf[ks], aS[2 * np + 1]); }
                asm volatile("" ::: "memory"); }
            f32x4 aC[3];
            { bf16x8 cf[2][4];
#pragma unroll
              for (int h = 0; h < 2; ++h)
#pragma unroll
                  for (int ks = 0; ks < 4; ++ks) cf[h][ks] = *(const LAS bf16x8*)(ctc + off_b(16 * h + l_loc, 4 * ks + g));
              asm volatile("" ::: "memory");
              aC[0] = (f32x4){0.f, 0.f, 0.f, 0.f}; aC[1] = (f32x4){0.f, 0.f, 0.f, 0.f};
#pragma unroll
              for (int ks = 0; ks < 4; ++ks) { aC[0] = MFMA16(cf[0][ks], qf[ks], aC[0]); aC[1] = MFMA16(cf[1][ks], qf[ks], aC[1]); }
              asm volatile("" ::: "memory");
#pragma unroll
              for (int ks = 0; ks < 4; ++ks) cf[0][ks] = *(const LAS bf16x8*)(ctc + off_b(32 + l_loc, 4 * ks + g));
              asm volatile("" ::: "memory");
              aC[2] = (f32x4){0.f, 0.f, 0.f, 0.f};
#pragma unroll
              for (int ks = 0; ks < 4; ++ks) aC[2] = MFMA16(cf[0][ks], qf[ks], aC[2]); }
            const float rowv_l = sc[64 + l], winter_l = sc[128 + l], emq_l = sc[192 + l];
            float rowsum = 0.f; unsigned pk[4][2];
#pragma unroll
            for (int nt = 0; nt < 4; ++nt) { const f32x4 a4 = *(const LAS f32x4*)(sc + 16 * nt + 4 * g); float p[4];
#pragma unroll
                for (int r = 0; r < 4; ++r) { const int s = 16 * nt + 4 * g + r; p[r] = (s <= l) ? aS[nt][r] * __expf(rowv_l + a4[r]) : 0.f; rowsum += p[r]; }
                pk[nt][0] = cvt_pk_bf16(p[0], p[1]); pk[nt][1] = cvt_pk_bf16(p[2], p[3]); }
            f32x4 aO[2];
#pragma unroll
            for (int cc = 0; cc < 2; ++cc) { aO[cc] = (f32x4){0.f, 0.f, 0.f, 0.f};
#pragma unroll
                for (int ks = 0; ks < 2; ++ks) {
                    const s16x4 lo = vtr(BV + (32 * ks + 4 * g + q4) * 64 + (16 * cc + 4 * p4) * 2), hi = vtr(BV + (32 * ks + 16 + 4 * g + q4) * 64 + (16 * cc + 4 * p4) * 2);
                    const u32x4 pw = (u32x4){pk[2 * ks][0], pk[2 * ks][1], pk[2 * ks + 1][0], pk[2 * ks + 1][1]};
                    aO[cc] = MFMA16(cat8(lo, hi), __builtin_bit_cast(bf16x8, pw), aO[cc]); } }
            const float qn = __shfl(aC[2][0], l_loc);
            float rs = rowsum; rs += __shfl_xor(rs, 16); rs += __shfl_xor(rs, 32);
            const float den = rs + winter_l * qn;
            const float inv = __builtin_amdgcn_rcpf(fmaxf(fabsf(den), emq_l));
            bf16_t* orow = hbuf + (tb + (size_t)c * 64 + l) * 1024 + hd * 256 + slice * 32 + 4 * g;
#pragma unroll
            for (int cc = 0; cc < 2; ++cc) { const f32x4 o = (aO[cc] + aC[cc] * winter_l) * inv; u32x2 w; w.x = cvt_pk_bf16(o[0], o[1]); w.y = cvt_pk_bf16(o[2], o[3]); *(u32x2*)(orow + 16 * cc) = w; }
        } else {
            const int w2 = wave - 4; const float decay_cur = sc[320];
#pragma unroll
            for (int i = 0; i < 2; ++i)
#pragma unroll
                for (int cc = 0; cc < 3; ++cc) st[i][cc] = st[i][cc] * decay_cur;
#pragma unroll
            for (int ks = 0; ks < 2; ++ks) {
                const f32x4 wl = *(const LAS f32x4*)(sc + 256 + 32 * ks + 8 * g), wh = *(const LAS f32x4*)(sc + 256 + 32 * ks + 8 * g + 4);
                bf16x8 vw[3];
#pragma unroll
                for (int cc = 0; cc < 2; ++cc) { const u32x2 lo = __builtin_bit_cast(u32x2, vtr(BV + (32 * ks + 8 * g + q4) * 64 + (16 * cc + 4 * p4) * 2)), hi = __builtin_bit_cast(u32x2, vtr(BV + (32 * ks + 8 * g + 4 + q4) * 64 + (16 * cc + 4 * p4) * 2));
                    const u32x4 sv_ = (u32x4){cvt_pk_bf16(bf_lo(lo.x) * wl[0], bf_hi(lo.x) * wl[1]), cvt_pk_bf16(bf_lo(lo.y) * wl[2], bf_hi(lo.y) * wl[3]), cvt_pk_bf16(bf_lo(hi.x) * wh[0], bf_hi(hi.x) * wh[1]), cvt_pk_bf16(bf_lo(hi.y) * wh[2], bf_hi(hi.y) * wh[3])};
                    vw[cc] = __builtin_bit_cast(bf16x8, sv_); }
                { const u32x4 on_ = (u32x4){cvt_pk_bf16(wl[0], wl[1]), cvt_pk_bf16(wl[2], wl[3]), cvt_pk_bf16(wh[0], wh[1]), cvt_pk_bf16(wh[2], wh[3])};
                  vw[2] = __builtin_bit_cast(bf16x8, l_loc == 0 ? on_ : (u32x4){0u, 0u, 0u, 0u}); }
#pragma unroll
                for (int i = 0; i < 2; ++i) { const int mt2 = 2 * w2 + i;
                    const bf16x8 kt = cat8(vtr(BQ + ML_K + off_b(32 * ks + 8 * g + q4, 2 * mt2 + (p4 >> 1)) + 8 * (p4 & 1)), vtr(BQ + ML_K + off_b(32 * ks + 8 * g + 4 + q4, 2 * mt2 + (p4 >> 1)) + 8 * (p4 & 1)));
#pragma unroll
                    for (int cc = 0; cc < 3; ++cc) st[i][cc] = MFMA16(kt, vw[cc], st[i][cc]); }
            }
#pragma unroll
            for (int i = 0; i < 2; ++i) { const int mt2 = 2 * w2 + i;
#pragma unroll
                for (int cc = 0; cc < 3; ++cc) { u32x2 w; w.x = cvt_pk_bf16(st[i][cc][0], st[i][cc][1]); w.y = cvt_pk_bf16(st[i][cc][2], st[i][cc][3]);
                    *(LAS u32x2*)(ctn + off_b(16 * cc + l_loc, 2 * mt2 + (g >> 1)) + 8 * (g & 1)) = w; } }
        }
        if (c + 2 < 64) { if (wave < 4) asm volatile("s_waitcnt vmcnt(7)" ::: "memory"); else if (wave < 6) asm volatile("s_waitcnt vmcnt(5)" ::: "memory"); else asm volatile("s_waitcnt vmcnt(4)" ::: "memory"); }
        else { if (wave < 4) asm volatile("s_waitcnt vmcnt(2)" ::: "memory"); else asm volatile("s_waitcnt vmcnt(0)" ::: "memory"); }
        __syncthreads();
        cb = cb == 2 ? 0 : cb + 1;
    }
#undef ML_DMA
#undef ML_ISSUE
}

template <int I0, int CNT>
__device__ __forceinline__ void conv_load(const bf16_t* z, int t0, int p0, int c0, unsigned (&ru)[16]) {
#pragma unroll
    for (int q = 0; q < CNT; ++q) { const int i = I0 + q; const bool ok = (p0 - 30 + i >= 0);
        ru[q] = *(const unsigned*)(z + (size_t)(ok ? t0 - 30 + i : t0) * ZW + c0); }
}
__device__ __forceinline__ float dot2bf(unsigned w, unsigned u, float c) { return __builtin_amdgcn_fdot2_f32_bf16(__builtin_bit_cast(bf16x2_t, w), __builtin_bit_cast(bf16x2_t, u), c, false); }
template <int I0, int CNT>
__device__ __forceinline__ void conv_use(int p0, const unsigned (&ru)[16], unsigned& prev, const unsigned (&w0)[16], const unsigned (&w1)[16], float (&y0)[16], float (&y1)[16]) {
    unsigned r[CNT + 1];
#pragma unroll
    for (int q = 0; q < CNT; ++q) r[q] = (p0 - 30 + I0 + q >= 0) ? ru[q] : 0u;
    r[CNT] = 0u;
#pragma unroll
    for (int m = 0; m < (CNT + 1) / 2; ++m) {
        const int s = I0 + 2 * m;
        const unsigned e0 = __builtin_amdgcn_perm(r[2 * m + 1], r[2 * m], 0x05040100u), e1 = __builtin_amdgcn_perm(r[2 * m + 1], r[2 * m], 0x07060302u);
#pragma unroll
        for (int jj = 0; jj < 16; ++jj) { const int t = s - 2 * jj; if (t >= 0 && t <= 15) { y0[t] = dot2bf(w0[jj], e0, y0[t]); y1[t] = dot2bf(w1[jj], e1, y1[t]); } }
    }
#pragma unroll
    for (int m = 0; m < CNT / 2 + (I0 + CNT == 46 ? 1 : 0); ++m) {
        const int s = I0 - 1 + 2 * m;
        if (s < 1 || s > 45) continue;
        const unsigned lo = (m == 0) ? prev : r[2 * m - 1], hi = r[2 * m];
        const unsigned o0 = __builtin_amdgcn_perm(hi, lo, 0x05040100u), o1 = __builtin_amdgcn_perm(hi, lo, 0x07060302u);
#pragma unroll
        for (int jj = 0; jj < 16; ++jj) { const int t = s - 2 * jj; if (t >= 0 && t <= 15) { y0[t] = dot2bf(w0[jj], o0, y0[t]); y1[t] = dot2bf(w1[jj], o1, y1[t]); } }
    }
    prev = r[CNT - 1];
}
__device__ __forceinline__ void conv_phase(const Args& a, LAS unsigned char* lds, int bid, int G, int tid) {
    const int lane = tid & 63, wave = tid >> 6, c0 = 2 * tid;
    const bf16_t* z = (const bf16_t*)(a.ws + WS_Z); unsigned char* ymix = a.ws + WS_YMIX;
    LAS float* red = (LAS float*)lds;
    unsigned w0[16], w1[16];
#pragma unroll
    for (int jj = 0; jj < 16; ++jj) { const f32x2 wa = *(const f32x2*)(a.in[I_DWW] + (2 * jj) * 1024 + c0); f32x2 wb = (f32x2){0.f, 0.f}; if (jj < 15) wb = *(const f32x2*)(a.in[I_DWW] + (2 * jj + 1) * 1024 + c0);
        w0[jj] = cvt_pk_bf16(wa[0], wb[0]); w1[jj] = cvt_pk_bf16(wa[1], wb[1]); }
    const f32x2 bias = *(const f32x2*)(a.in[I_DWB] + c0);
    const f32x2 lg = *(const f32x2*)(a.in[I_CLG] + c0), lb = *(const f32x2*)(a.in[I_CLB] + c0);
    unsigned ra0[16], ra1[16];
    int unit = bid;
    if (unit < T / 16) conv_load<0, 16>(z, unit * 16, (unit * 16) & (SEQ - 1), c0, ra0);
    for (int it_ = 0; unit < T / 16; unit += G, ++it_) {
        const int t0 = unit * 16, p0 = t0 & (SEQ - 1);
        const int un = (unit + G < T / 16) ? unit + G : unit, tn = un * 16, pn = tn & (SEQ - 1);
        float y0[16], y1[16]; unsigned prev = 0u;
#pragma unroll
        for (int t = 0; t < 16; ++t) { y0[t] = bias[0]; y1[t] = bias[1]; }
#define CV_FENCE() asm volatile("" ::: "memory")
        conv_load<16, 16>(z, t0, p0, c0, ra1); CV_FENCE(); conv_use<0, 16>(p0, ra0, prev, w0, w1, y0, y1);  CV_FENCE();
        conv_load<32, 14>(z, t0, p0, c0, ra0); CV_FENCE(); conv_use<16, 16>(p0, ra1, prev, w0, w1, y0, y1); CV_FENCE();
        conv_use<32, 14>(p0, ra0, prev, w0, w1, y0, y1); CV_FENCE();
        conv_load<0, 16>(z, tn, pn, c0, ra0);  CV_FENCE();
#undef CV_FENCE
        { LAS float* rb = red + (it_ & 1) * (8 * 32);
#pragma unroll
          for (int t = 0; t < 16; ++t) { const float s1 = wave_sum(y0[t] + y1[t]), s2 = wave_sum(y0[t] * y0[t] + y1[t] * y1[t]); if (lane == 0) { rb[(wave * 16 + t) * 2] = s1; rb[(wave * 16 + t) * 2 + 1] = s2; } }
          __syncthreads();
          float s1 = 0.f, s2 = 0.f;
#pragma unroll
          for (int ww = 0; ww < 8; ++ww) { const f32x2 pr = *(const LAS f32x2*)(rb + (ww * 16 + (lane & 15)) * 2); s1 += pr[0]; s2 += pr[1]; }
          const float meanv = s1 * (1.0f / 1024.0f), varv = fmaxf(s2 * (1.0f / 1024.0f) - meanv * meanv, 0.f), rstdv = 1.0f / sqrtf(varv + LN_EPS);
#pragma unroll
          for (int t = 0; t < 16; ++t) { const float mean = __uint_as_float(__builtin_amdgcn_readlane(__float_as_uint(meanv), t)), rstd = __uint_as_float(__builtin_amdgcn_readlane(__float_as_uint(rstdv), t));
              const float v0 = (y0[t] - mean) * rstd * lg[0] + lb[0], v1 = (y1[t] - mean) * rstd * lg[1] + lb[1];
              *(unsigned short*)(ymix + (size_t)(t0 + t) * D + c0) = (unsigned short)__builtin_amdgcn_cvt_pk_fp8_f32(v0 * sigmoidf_(v0), v1 * sigmoidf_(v1), 0, false); } }
    }
}

__device__ __forceinline__ void phase_postnorm(const Args& a, int bid, int G, int tid) {
    const int lane = tid & 63, wave = tid >> 6;
    const bf16_t* z = (const bf16_t*)(a.ws + WS_Z); const bf16_t* hbuf = (const bf16_t*)(a.ws + WS_HBUF); unsigned char* ymix = a.ws + WS_YMIX;
    f32x4 gg[4];
#pragma unroll
    for (int j = 0; j < 4; ++j) gg[j] = *(const f32x4*)(a.in[I_MHG] + 16 * lane + 4 * j);
    for (int row = bid * 8 + wave; row < T; row += G * 8) {
        const u32x4* hp = (const u32x4*)(hbuf + (size_t)row * 1024 + 16 * lane); const u32x4* op = (const u32x4*)(z + (size_t)row * ZW + 3072 + 16 * lane);
        const u32x4 h0 = hp[0], h1 = hp[1], o0 = op[0], o1 = op[1];
        float hv[16], ov[16];
        hv[0] = bf_lo(h0.x); hv[1] = bf_hi(h0.x); hv[2] = bf_lo(h0.y); hv[3] = bf_hi(h0.y); hv[4] = bf_lo(h0.z); hv[5] = bf_hi(h0.z); hv[6] = bf_lo(h0.w); hv[7] = bf_hi(h0.w);
        hv[8] = bf_lo(h1.x); hv[9] = bf_hi(h1.x); hv[10] = bf_lo(h1.y); hv[11] = bf_hi(h1.y); hv[12] = bf_lo(h1.z); hv[13] = bf_hi(h1.z); hv[14] = bf_lo(h1.w); hv[15] = bf_hi(h1.w);
        ov[0] = bf_lo(o0.x); ov[1] = bf_hi(o0.x); ov[2] = bf_lo(o0.y); ov[3] = bf_hi(o0.y); ov[4] = bf_lo(o0.z); ov[5] = bf_hi(o0.z); ov[6] = bf_lo(o0.w); ov[7] = bf_hi(o0.w);
        ov[8] = bf_lo(o1.x); ov[9] = bf_hi(o1.x); ov[10] = bf_lo(o1.y); ov[11] = bf_hi(o1.y); ov[12] = bf_lo(o1.z); ov[13] = bf_hi(o1.z); ov[14] = bf_lo(o1.w); ov[15] = bf_hi(o1.w);
        float ss = 0.f;
#pragma unroll
        for (int i = 0; i < 16; ++i) ss += hv[i] * hv[i];
        ss = row16_sum(ss);
        const float rs = 1.0f / sqrtf(ss * (1.0f / 256.0f) + LN_EPS);
        float ov2[16];
#pragma unroll
        for (int i = 0; i < 16; ++i) ov2[i] = hv[i] * rs * gg[i >> 2][i & 3] * sigmoidf_(ov[i]);
        u32x4 w0; w0.x = cvt4_fp8(ov2[0], ov2[1], ov2[2], ov2[3]); w0.y = cvt4_fp8(ov2[4], ov2[5], ov2[6], ov2[7]); w0.z = cvt4_fp8(ov2[8], ov2[9], ov2[10], ov2[11]); w0.w = cvt4_fp8(ov2[12], ov2[13], ov2[14], ov2[15]);
        *(u32x4*)(ymix + (size_t)row * D + 1024 + 16 * lane) = w0;
    }
}

typedef int i32x4v __attribute__((ext_vector_type(4)));
constexpr int P6_TILE = 32768  , P6_TSTR = 1032  , P6_TLO = 16 * P6_TSTR * 2  , P6_RED = P6_TILE + 2 * P6_TLO, P6_HIST = P6_RED + 8 * 16 * 32 * 4, P6_LN1 = 16384;
__device__ __forceinline__ void p6_put(LAS unsigned char* tile, int row, int ch, f32x4 v) {
    const unsigned h0 = cvt_pk_bf16(v[0], v[1]), h1 = cvt_pk_bf16(v[2], v[3]);
    const unsigned l0 = cvt_pk_bf16(v[0] - bf_lo(h0), v[1] - bf_hi(h0)), l1 = cvt_pk_bf16(v[2] - bf_lo(h1), v[3] - bf_hi(h1));
    *(LAS u32x2*)(tile + row * (P6_TSTR * 2) + ch * 2) = (u32x2){h0, h1}; *(LAS u32x2*)(tile + P6_TLO + row * (P6_TSTR * 2) + ch * 2) = (u32x2){l0, l1};
}
__device__ __forceinline__ void phase6(const Args& a, LAS unsigned char* lds, int bid, int G, int tid) {
    const int lane = tid & 63, wave = tid >> 6;
    LAS float* s_sc = (LAS float*)lds; LAS float* s_sh = s_sc + 2048;
    LAS unsigned char* tile = lds + P6_TILE; LAS float* red = (LAS float*)(lds + P6_RED); LAS int* hist = (LAS int*)(lds + P6_HIST);
    LAS float* s_g1 = (LAS float*)(lds + P6_LN1); LAS float* s_b1 = s_g1 + 2048;
    const float* mod = (const float*)(a.ws + WS_MOD); const bf16_t* r = (const bf16_t*)(a.ws + WS_R); float* stat = (float*)(a.ws + WS_STAT); unsigned char* h2 = a.ws + WS_H8;
    const float* rw = a.in[I_RW];
    int* tok_e = (int*)(a.ws + WS_TOKE); float* tok_w = (float*)(a.ws + WS_TOKW); int* tok_p = (int*)(a.ws + WS_TOKP); int* wgcnt = (int*)(a.ws + WS_WGCNT);
    const float rb_l = a.in[I_RB][lane & 31];
    float bhi[2][4][2][4], blo[2][4][2][4];
    { const u32x4* tb = (const u32x4*)(a.ws + WS_WRT) + (size_t)(wave * 16) * 2 * 64 + lane;
#pragma unroll
      for (int c = 0; c < 2; ++c)
#pragma unroll
          for (int ks = 0; ks < 4; ++ks)
#pragma unroll
              for (int h = 0; h < 2; ++h) { const int f = (c * 4 + ks) * 2 + h; const u32x4 hv_ = tb[(f * 2) * 64], lv_ = tb[(f * 2 + 1) * 64];
#pragma unroll
                  for (int q = 0; q < 4; ++q) { asm volatile("v_accvgpr_write_b32 %0, %1" : "=a"(bhi[c][ks][h][q]) : "v"(hv_[q])); asm volatile("v_accvgpr_write_b32 %0, %1" : "=a"(blo[c][ks][h][q]) : "v"(lv_[q])); }
                  if (h == 1) asm volatile("" ::: "memory"); } }
    for (int p = bid; p < T / 128; p += G) {
        const int b = (p * 128) / SEQ;
        __syncthreads();
        { int l_; asm volatile("v_mbcnt_lo_u32_b32 %0, -1, 0\n\tv_mbcnt_hi_u32_b32 %0, -1, %0" : "=v"(l_)); const int t0 = __builtin_amdgcn_readfirstlane(wave) * 64 + l_;
          for (int i = t0; i < 2048; i += 512) { s_sh[i] = mod[b * 12288 + 6144 + i]; s_sc[i] = 1.0f + mod[b * 12288 + 8192 + i]; s_g1[i] = a.in[I_LN1G][i]; s_b1[i] = a.in[I_LN1B][i]; } }
        __syncthreads();
        u32x2 raw[2][8];
#pragma unroll
        for (int rr = 0; rr < 2; ++rr) { const u32x2* xr = (const u32x2*)(r + (size_t)(p * 128 + 2 * wave + rr) * D) + lane;
#pragma unroll
            for (int j = 0; j < 8; ++j) raw[rr][j] = xr[64 * j]; }
        for (int tl = 0; tl < 8; ++tl) {
            f32x4 hc1[2][4];
#pragma unroll
            for (int rr = 0; rr < 2; ++rr) {
                const int row = p * 128 + tl * 16 + 2 * wave + rr;
                f32x4 v[8]; float s = 0.f;
#pragma unroll
                for (int j = 0; j < 8; ++j) { const u32x2 rv = raw[rr][j]; v[j] = (f32x4){bf_lo(rv.x), bf_hi(rv.x), bf_lo(rv.y), bf_hi(rv.y)}; s += (v[j][0] + v[j][1]) + (v[j][2] + v[j][3]); }
                float mean = wave_sum(s) * (1.0f / D), s2 = 0.f;
#pragma unroll
                for (int j = 0; j < 8; ++j) { v[j] = v[j] - mean; s2 += (v[j][0] * v[j][0] + v[j][1] * v[j][1]) + (v[j][2] * v[j][2] + v[j][3] * v[j][3]); }
                float rstd = 1.0f / sqrtf(wave_sum(s2) * (1.0f / D) + LN_EPS);
                if (lane == 0) *(f32x2*)(stat + (size_t)row * 2) = (f32x2){mean, rstd};
                s = 0.f;
#pragma unroll
                for (int j = 0; j < 8; ++j) { const f32x4 gq = *(const LAS f32x4*)(s_g1 + 4 * lane + 256 * j), bq = *(const LAS f32x4*)(s_b1 + 4 * lane + 256 * j);
                    v[j] = v[j] * rstd * gq + bq; s += (v[j][0] + v[j][1]) + (v[j][2] + v[j][3]); }
                mean = wave_sum(s) * (1.0f / D); s2 = 0.f;
#pragma unroll
                for (int j = 0; j < 8; ++j) { v[j] = v[j] - mean; s2 += (v[j][0] * v[j][0] + v[j][1] * v[j][1]) + (v[j][2] * v[j][2] + v[j][3] * v[j][3]); }
                rstd = 1.0f / sqrtf(wave_sum(s2) * (1.0f / D) + LN_EPS);
                unsigned* o4 = (unsigned*)(h2 + (size_t)row * D) + lane;
#pragma unroll
                for (int j = 0; j < 8; ++j) { const f32x4 sc = *(const LAS f32x4*)(s_sc + 4 * lane + 256 * j), sh = *(const LAS f32x4*)(s_sh + 4 * lane + 256 * j);
                    const f32x4 hq = v[j] * rstd * sc + sh; o4[64 * j] = cvt4_fp8(hq[0], hq[1], hq[2], hq[3]);
                    if (j < 4) p6_put(tile, 2 * wave + rr, 4 * lane + 256 * j, hq); else hc1[rr][j - 4] = hq; }
                asm volatile("" ::: "memory");
            }
            {
                const int tn = tl < 7 ? tl + 1 : tl;
#pragma unroll
                for (int rr = 0; rr < 2; ++rr) { const u32x2* xr = (const u32x2*)(r + (size_t)(p * 128 + tn * 16 + 2 * wave + rr) * D) + lane;
#pragma unroll
                    for (int j = 0; j < 8; ++j) raw[rr][j] = xr[64 * j]; }
            }
            f32x4 acc0 = (f32x4){0.f, 0.f, 0.f, 0.f}, acc1 = (f32x4){0.f, 0.f, 0.f, 0.f};
#pragma unroll
            for (int c = 0; c < 2; ++c) {
                if (c == 1) {
                    __syncthreads();
#pragma unroll
                    for (int rr = 0; rr < 2; ++rr)
#pragma unroll
                        for (int jj = 0; jj < 4; ++jj) p6_put(tile, 2 * wave + rr, 4 * lane + 256 * jj, hc1[rr][jj]);
                }
                __syncthreads();
                const LAS unsigned char* ap = tile + (lane & 15) * (P6_TSTR * 2) + (128 * wave + 8 * (lane >> 4)) * 2;
#pragma unroll
                for (int ks = 0; ks < 4; ++ks) { const bf16x8 ah = *(const LAS bf16x8*)(ap + 64 * ks), al = *(const LAS bf16x8*)(ap + P6_TLO + 64 * ks);
#pragma unroll
                    for (int h = 0; h < 2; ++h) {
#pragma unroll
                        for (int q = 0; q < 4; ++q) asm volatile("" : "+a"(bhi[c][ks][h][q]), "+a"(blo[c][ks][h][q]));
                        const bf16x8 bh = __builtin_bit_cast(bf16x8, (f32x4){bhi[c][ks][h][0], bhi[c][ks][h][1], bhi[c][ks][h][2], bhi[c][ks][h][3]});
                        const bf16x8 bl = __builtin_bit_cast(bf16x8, (f32x4){blo[c][ks][h][0], blo[c][ks][h][1], blo[c][ks][h][2], blo[c][ks][h][3]});
                        f32x4& ac = h ? acc1 : acc0;
                        ac = MFMA16(ah, bh, ac); ac = MFMA16(ah, bl, ac); ac = MFMA16(al, bh, ac); } }
            }
#pragma unroll
            for (int q = 0; q < 4; ++q) { red[(wave * 16 + 4 * (lane >> 4) + q) * 32 + (lane & 15)] = acc0[q]; red[(wave * 16 + 4 * (lane >> 4) + q) * 32 + 16 + (lane & 15)] = acc1[q]; }
            __syncthreads();
            float mylog = rb_l;
#pragma unroll
            for (int w = 0; w < 8; ++w) mylog += red[(w * 16 + 2 * wave + (lane >> 5)) * 32 + (lane & 31)];
            float cur = mylog; float tv[4]; int ti[4];
#pragma unroll
            for (int k = 0; k < 4; ++k) {
                float bv = cur; int bi = lane & 31;
#define P6_AM(ctrl_) do { const float ov = __int_as_float(__builtin_amdgcn_update_dpp(0, __float_as_int(bv), ctrl_, 0xF, 0xF, true)); const int oi = __builtin_amdgcn_update_dpp(0, bi, ctrl_, 0xF, 0xF, true); \
                    const bool tk_ = (ov > bv) | ((ov == bv) & (oi < bi)); bv = tk_ ? ov : bv; bi = tk_ ? oi : bi; } while (0)
                P6_AM(0xB1); P6_AM(0x4E); P6_AM(0x141); P6_AM(0x140);
#undef P6_AM
                { const auto rv = __builtin_amdgcn_permlane16_swap(__float_as_uint(bv), __float_as_uint(bv), false, false); const auto ri = __builtin_amdgcn_permlane16_swap((unsigned)bi, (unsigned)bi, false, false);
                  const float v0 = __uint_as_float(rv[0]), v1 = __uint_as_float(rv[1]); const int i0 = (int)ri[0], i1 = (int)ri[1];
                  const bool tk_ = (v1 > v0) | ((v1 == v0) & (i1 < i0)); bv = tk_ ? v1 : v0; bi = tk_ ? i1 : i0; }
                tv[k] = bv; ti[k] = bi; if ((lane & 31) == bi) cur = -3.0e38f;
            }
            const float e1 = __expf(tv[1] - tv[0]), e2 = __expf(tv[2] - tv[0]), e3 = __expf(tv[3] - tv[0]); const float inv = 1.0f / (1.0f + e1 + e2 + e3);
            if ((lane & 31) < 4) {
                const int k = lane & 3, rt = tl * 16 + 2 * wave + (lane >> 5), row = p * 128 + rt;
                const int ee = (k == 0) ? ti[0] : (k == 1) ? ti[1] : (k == 2) ? ti[2] : ti[3];
                const float ww = ((k == 0) ? 1.0f : (k == 1) ? e1 : (k == 2) ? e2 : e3) * inv;
                tok_e[row * 4 + k] = ee; tok_w[row * 4 + k] = ww; hist[rt * 4 + k] = ee;
            }
        }
        __syncthreads();
        if (wave == 0) {
            int base = 0;
            for (int ch = 0; ch < 8; ++ch) {
                const int ee = hist[ch * 64 + lane];
                const int pbase = __shfl(base, ee);
                unsigned long long mym = 0ull;
                for (int e = 0; e < 32; ++e) { const unsigned long long m = __ballot(ee == e); if (ee == e) mym = m; if (lane == e) base += __popcll(m); }
                const int rank = __popcll(mym & ((1ull << lane) - 1ull));
                tok_p[p * 512 + ch * 64 + lane] = pbase + rank;
            }
            if (lane < 32) wgcnt[p * 32 + lane] = base;
        }
    }
}

__device__ __forceinline__ void phase7(const Args& a, LAS unsigned char* lds, int bid, int G, int tid) {
    LAS int* pre = (LAS int*)lds;
    LAS int* tot = pre + 8192;
    LAS int* pst = tot + 32;
    const int* wgcnt = (const int*)(a.ws + WS_WGCNT); const int* tok_e = (const int*)(a.ws + WS_TOKE); int* tok_p = (int*)(a.ws + WS_TOKP);
    int* row_tok = (int*)(a.ws + WS_ROWTOK); int* tile_e = (int*)(a.ws + WS_TILEE);
    __syncthreads();
    for (int i = tid; i < 8192; i += 512) pre[i] = wgcnt[i];
    __syncthreads();
    {
        LAS int* seg = pst + 64;
        const int e = tid & 31, sg = tid >> 5; int run = 0;
        for (int w = 16 * sg; w < 16 * sg + 16; ++w) { const int c = pre[w * 32 + e]; pre[w * 32 + e] = run; run += c; }
        seg[sg * 32 + e] = run;
        __syncthreads();
        if (tid < 32) { int r2 = 0; for (int q = 0; q < 16; ++q) { const int c = seg[q * 32 + tid]; seg[q * 32 + tid] = r2; r2 += c; } tot[tid] = r2; }
        __syncthreads();
        const int base = seg[sg * 32 + e];
        for (int w = 16 * sg; w < 16 * sg + 16; ++w) pre[w * 32 + e] += base;
    }
    __syncthreads();
    if (tid == 0) { int run = 0; for (int e = 0; e < 32; ++e) { pst[e] = run; run += (tot[e] + 255) & ~255; } pst[32] = run; }
    __syncthreads();
    for (int p = bid; p < T / 128; p += G) {
        const int t = p * 128 + (tid >> 2), k = tid & 3, e = tok_e[t * 4 + k], lp = tok_p[t * 4 + k];
        const int slot = pst[e] + pre[p * 32 + e] + lp;
        row_tok[slot] = t; tok_p[t * 4 + k] = slot;
    }
    if (bid == 0) {
        for (int e = 0; e < 32; ++e) { const int s0 = pst[e] + tot[e], s1 = pst[e + 1]; for (int s = s0 + tid; s < s1; s += 512) row_tok[s] = 0; }
        const int ntl = pst[32] >> 8;
        for (int i = tid; i < ntl; i += 512) { int e = 0; for (int q = 1; q < 32; ++q) if ((pst[q] >> 8) <= i) e = q; tile_e[i] = e; }
        if (tid == 0) tile_e[1024] = ntl;
    }
}

__device__ __forceinline__ void phase10(const Args& a, LAS unsigned char* lds, int bid, int G, int tid) {
    const int lane = tid & 63, wave = tid >> 6;
    const float* mod = (const float*)(a.ws + WS_MOD); const bf16_t* rr = (const bf16_t*)(a.ws + WS_R); const float* stat = (const float*)(a.ws + WS_STAT); const unsigned char* yb = a.ws + WS_YB;
    const float* tok_w = (const float*)(a.ws + WS_TOKW); const int* tok_s = (const int*)(a.ws + WS_TOKP);
    LAS float* s_g2 = (LAS float*)lds; LAS float* s_lg = s_g2 + 2048; LAS float* s_lb = s_lg + 2048; LAS float* s_g1 = s_lb + 2048; LAS float* s_b1 = s_g1 + 2048;
    for (int p = bid; p < T / 128; p += G) {
        const int b = (p * 128) / SEQ;
        __syncthreads();
        for (int i = tid; i < 2048; i += 512) { s_g2[i] = mod[(size_t)b * 12288 + 10240 + i]; s_lg[i] = a.in[I_LN2G][i]; s_lb[i] = a.in[I_LN2B][i]; s_g1[i] = ALPHA * a.in[I_LN1G][i]; s_b1[i] = ALPHA * a.in[I_LN1B][i]; }
        __syncthreads();
        int nslot[4]; float nw[4]; f32x2 nst = *(const f32x2*)(stat + (size_t)(p * 128 + wave) * 2);
#pragma unroll
        for (int k = 0; k < 4; ++k) { nslot[k] = tok_s[(p * 128 + wave) * 4 + k]; nw[k] = tok_w[(p * 128 + wave) * 4 + k]; }
        for (int r = wave; r < 128; r += 8) {
            const int row = p * 128 + r;
            int slot[4]; float wk4[4];
#pragma unroll
            for (int k = 0; k < 4; ++k) { slot[k] = __builtin_amdgcn_readfirstlane(nslot[k]); wk4[k] = __uint_as_float(__builtin_amdgcn_readfirstlane(__float_as_uint(nw[k]))) * 0.125f; }
            const float mean1 = nst[0], rstd1 = nst[1];
            { const int rn = r + 8 < 128 ? r + 8 : r; nst = *(const f32x2*)(stat + (size_t)(p * 128 + rn) * 2);
#pragma unroll
              for (int k = 0; k < 4; ++k) { nslot[k] = tok_s[(p * 128 + rn) * 4 + k]; nw[k] = tok_w[(p * 128 + rn) * 4 + k]; } }
            float acc[32];
#pragma unroll
            for (int i = 0; i < 32; ++i) acc[i] = 0.f;
#pragma unroll
            for (int hf = 0; hf < 2; ++hf) {
#pragma unroll
                for (int k = 0; k < 4; ++k) { const u32x2* yp = (const u32x2*)(yb + (size_t)slot[k] * D) + lane; const float w = wk4[k];
#pragma unroll
                    for (int j = 2 * hf; j < 2 * hf + 2; ++j) { const u32x2 v = yp[64 * j];
                        const f32x2 p0 = __builtin_amdgcn_cvt_pk_f32_fp8((int)v.x, false), p1 = __builtin_amdgcn_cvt_pk_f32_fp8((int)v.x, true), p2 = __builtin_amdgcn_cvt_pk_f32_fp8((int)v.y, false), p3 = __builtin_amdgcn_cvt_pk_f32_fp8((int)v.y, true);
                        acc[8 * j + 0] += w * p0[0]; acc[8 * j + 1] += w * p0[1]; acc[8 * j + 2] += w * p1[0]; acc[8 * j + 3] += w * p1[1];
                        acc[8 * j + 4] += w * p2[0]; acc[8 * j + 5] += w * p2[1]; acc[8 * j + 6] += w * p3[0]; acc[8 * j + 7] += w * p3[1]; } }
                asm volatile("" ::: "memory");
            }
            float s = 0.f;
#pragma unroll
            for (int j = 0; j < 4; ++j) {
                const int ch = 8 * lane + 512 * j;
                const u32x4 xv = *(const u32x4*)(rr + (size_t)row * D + ch);
                const f32x4 xa = ((f32x4){bf_lo(xv.x), bf_hi(xv.x), bf_lo(xv.y), bf_hi(xv.y)} - mean1) * rstd1, xb = ((f32x4){bf_lo(xv.z), bf_hi(xv.z), bf_lo(xv.w), bf_hi(xv.w)} - mean1) * rstd1;
                const f32x4 ga = *(const LAS f32x4*)(s_g2 + ch), gb = *(const LAS f32x4*)(s_g2 + ch + 4);
                const f32x4 la = *(const LAS f32x4*)(s_g1 + ch), lb = *(const LAS f32x4*)(s_g1 + ch + 4), ca = *(const LAS f32x4*)(s_b1 + ch), cb = *(const LAS f32x4*)(s_b1 + ch + 4);
#pragma unroll
                for (int i = 0; i < 4; ++i) { acc[8 * j + i] = (xa[i] * la[i] + ca[i]) + ga[i] * acc[8 * j + i]; acc[8 * j + 4 + i] = (xb[i] * lb[i] + cb[i]) + gb[i] * acc[8 * j + 4 + i]; }
#pragma unroll
                for (int i = 0; i < 8; ++i) s += acc[8 * j + i];
            }
            const float mean = wave_sum(s) * (1.0f / D); float s2 = 0.f;
#pragma unroll
            for (int i = 0; i < 32; ++i) { acc[i] -= mean; s2 += acc[i] * acc[i]; }
            const float rstd = 1.0f / sqrtf(wave_sum(s2) * (1.0f / D) + LN_EPS);
#pragma unroll
            for (int j = 0; j < 4; ++j) {
                const int ch = 8 * lane + 512 * j;
                const f32x4 ga = *(const LAS f32x4*)(s_lg + ch), gb = *(const LAS f32x4*)(s_lg + ch + 4), ba = *(const LAS f32x4*)(s_lb + ch), bb = *(const LAS f32x4*)(s_lb + ch + 4);
                f32x4 oa, ob;
#pragma unroll
                for (int i = 0; i < 4; ++i) { oa[i] = acc[8 * j + i] * rstd * ga[i] + ba[i]; ob[i] = acc[8 * j + 4 + i] * rstd * gb[i] + bb[i]; }
                *(f32x4*)(a.out + (size_t)row * D + ch) = oa; *(f32x4*)(a.out + (size_t)row * D + ch + 4) = ob;
            }
        }
    }
}
__device__ __forceinline__ int fresh_tid(int wave_s) { int l; asm volatile("v_mbcnt_lo_u32_b32 %0, -1, 0\n\tv_mbcnt_hi_u32_b32 %0, -1, %0" : "=v"(l)); return wave_s * 64 + l; }
__global__ void __launch_bounds__(512, 2) hybrid_fwd(Args args) {
    extern __shared__ __attribute__((aligned(16))) unsigned char lds_raw[];
    LAS unsigned char* lds = (LAS unsigned char*)lds_raw;
    const int bid = blockIdx.x, G = gridDim.x;
    const int wave_s = __builtin_amdgcn_readfirstlane((int)threadIdx.x >> 6);
#define TID() fresh_tid(wave_s)
    const int vcu = (G % 8 == 0) ? (bid % 8) * (G / 8) + bid / 8 : bid;
    volatile LAS unsigned* MISC = (volatile LAS unsigned*)(lds + MISC_OFF);
    { const int tid = TID(); if (tid < 32) MISC[tid] = 0u; }
    __syncthreads();
    const int lo = args.ph_lo, hi = args.ph_hi;
    unsigned* barw = (unsigned*)(args.ws + WS_CTL) + CW_BAR;
    XcdBarrier bar; bar.bar = barw; bar.x = 0; bar.st = MISC + 8;
    if (hi - lo > 1) bar = xcd_barrier_post(barw, MISC + 8, TID());
#ifndef PHMASK
#define PHMASK 0x7ff
#endif
#ifndef REPMASK
#define REPMASK 0
#endif
#define IN(k) (((PHMASK >> (k)) & 1) && lo <= (k) && (k) < hi)
#define REP(k) for (int rep_ = 0; rep_ < (((REPMASK >> (k)) & 1) ? 2 : 1); ++rep_)
#define SEAM(k) do { if (IN(k) && IN((k) + 1)) xcd_barrier(bar, TID()); } while (0)

    if (IN(0)) REP(0) { phase0(args, lds, bid, G, TID()); } SEAM(0);
    if (IN(1)) REP(1) { phase1(args, lds, bid, G, TID()); } SEAM(1);
    if (IN(2)) REP(2) {
        { pg8::ProbPlain8 P{args.ws + WS_HF8, args.ws + WS_WTIN, D, SCALE_ONE, SCALE_W};
          pg8::TileOrder S; S.init(T / 256, 8, G, bid);
          pg8::EpiGLU E{(bf16_t*)(args.ws + WS_Z), args.in[I_BIN]};
          pg8::gemm_phase<pg8::EpiGLU, pg8::ProbPlain8>(lds, P, S, E, TID()); }
        { pg8::ProbPlain8 P{args.ws + WS_HF8, args.ws + WS_WTIN + (size_t)2048 * D, D, SCALE_ONE, SCALE_W};
          pg8::TileOrder S; S.init(T / 256, 12, G, bid);
          pg8::EpiZ E{(bf16_t*)(args.ws + WS_Z), args.in[I_BIN], 1024, 2048, 2};
          pg8::gemm_phase<pg8::EpiZ, pg8::ProbPlain8>(lds, P, S, E, TID()); }
    } SEAM(2);
    if (IN(3)) REP(3) {
        REP(12) for (int u = vcu; u < 256; u += G) { __syncthreads(); mlstm_chain(args, lds, u >> 3, u & 7, TID()); }
        __syncthreads();
        REP(11) conv_phase(args, lds, bid, G, TID());
    } SEAM(3);
    if (IN(4)) REP(4) { phase_postnorm(args, bid, G, TID()); } SEAM(4);
    if (IN(5)) REP(5) {
        pg8::ProbPlain8 P{args.ws + WS_YMIX, args.ws + WS_WTOUT, D, SCALE_ONE, SCALE_W};
        pg8::TileOrder S; S.init(T / 256, D / 256, G, bid);
        pg8::EpiR E{(bf16_t*)(args.ws + WS_R), args.in[I_X], (const float*)(args.ws + WS_MOD)};
        pg8::gemm_phase<pg8::EpiR, pg8::ProbPlain8>(lds, P, S, E, TID());
    } SEAM(5);
    if (IN(6)) REP(6) { phase6(args, lds, bid, G, TID()); } SEAM(6);
    if (IN(7)) { phase7(args, lds, bid, G, TID()); } SEAM(7);
    if (IN(8)) REP(8) {
        const int* tile_e = (const int*)(args.ws + WS_TILEE);
        const int ntl = __builtin_amdgcn_readfirstlane(tile_e[1024]);
        pg8::ProbGather P{args.ws + WS_H8, args.ws + WS_WTGU, D, 4096, tile_e, (const int*)(args.ws + WS_ROWTOK), SCALE_ONE, SCALE_W};
        pg8::TileOrder S; S.init(ntl, 16, G, bid);
        pg8::EpiAct E{args.ws + WS_ACT, args.in[I_BG], args.in[I_BU], tile_e};
        pg8::gemm_phase<pg8::EpiAct, pg8::ProbGather>(lds, P, S, E, TID());
    } SEAM(8);
    if (IN(9)) REP(9) {
        const int* tile_e = (const int*)(args.ws + WS_TILEE);
        const int ntl = __builtin_amdgcn_readfirstlane(tile_e[1024]);
        pg8::ProbExpert P{args.ws + WS_ACT, args.ws + WS_WTDN, D, 2048, tile_e, SCALE_ACT8, SCALE_W};
        pg8::TileOrder S; S.init(ntl, 8, G, bid);
        pg8::EpiY E{args.ws + WS_YB, args.in[I_BD], tile_e};
        pg8::gemm_phase<pg8::EpiY, pg8::ProbExpert>(lds, P, S, E, TID());
    } SEAM(9);
    if (IN(10)) REP(10) { phase10(args, lds, bid, G, TID()); }
#undef TID
#undef IN
#undef SEAM
}

#ifndef MK_PER_PHASE
#define MK_PER_PHASE 0
#endif
extern "C" void kernel_launch(void* const* d_in, const int* in_sizes, int n_in, void* d_out, int out_size, void* d_ws, size_t ws_size, hipStream_t stream) {
    static int grid = 0;
    if (grid == 0) {
        if (n_in != 24 || out_size != T * D || ws_size < WS_END) { fprintf(stderr, "kernel_launch: unexpected shapes (n_in %d, out %d, ws %zu); nothing launched\n", n_in, out_size, ws_size); grid = -1; return; }
        int dev = 0, cus = 0;
        if (hipGetDevice(&dev) != hipSuccess || hipDeviceGetAttribute(&cus, hipDeviceAttributeMultiprocessorCount, dev) != hipSuccess) { grid = -1; return; }
        if (hipFuncSetAttribute((const void*)hybrid_fwd, hipFuncAttributeMaxDynamicSharedMemorySize, LDS_BYTES) != hipSuccess) { fprintf(stderr, "kernel_launch: hipFuncSetAttribute failed\n"); grid = -1; return; }
        int per_cu = 0;
        if (hipOccupancyMaxActiveBlocksPerMultiprocessor(&per_cu, (const void*)hybrid_fwd, 512, LDS_BYTES) != hipSuccess || per_cu < 1) fprintf(stderr, "kernel_launch: occupancy query says %d\n", per_cu);
        (void)hipGetLastError();
        grid = cus;
    }
    if (grid < 0) return;
    (void)in_sizes;
    (void)hipMemsetAsync((char*)d_ws + WS_CTL, 0, CTL_ZERO_BYTES, stream);
    Args a{};
    for (int i = 0; i < 24; ++i) a.in[i] = (const float*)d_in[i];
    a.out = (float*)d_out; a.ws = (unsigned char*)d_ws;
#if MK_PER_PHASE
    for (int p = 0; p < NPH; ++p) { a.ph_lo = p; a.ph_hi = p + 1; hipLaunchKernelGGL(hybrid_fwd, dim3(grid), dim3(512), LDS_BYTES, stream, a); }
#else
    a.ph_lo = 0; a.ph_hi = NPH; hipLaunchKernelGGL(hybrid_fwd, dim3(grid), dim3(512), LDS_BYTES, stream, a);
#endif
}
```
